# Optimizing an MI355X kernel written in HIP

```python
import math
import jax, jax.numpy as jnp
from jax import lax
import numpy as np

D_MODEL = 1024
BATCH = 2
SEQ = 8192
DEPTH = 1

D_MIX = D_MODEL
D_ATT = D_MIX // 2
D_HYENA = D_MIX - D_ATT
DIFF_HEAD_DIM = 64
V_HEAD_DIM = 2 * DIFF_HEAD_DIM
N_DIFF_HEADS = D_ATT // V_HEAD_DIM
N_HYENA_GROUPS = 8
HYENA_GROUP_DIM = D_HYENA // N_HYENA_GROUPS
D_IN = 3 * D_ATT + 3 * D_HYENA
HYENA_SHORT_CONV = 3
HYENA_EMB_DIM = 33
HYENA_FILTER_ORDER = 64
HYENA_DECAY_TARGET = 1e-2
HYENA_FAST_DECAY = 0.3
HYENA_SLOW_DECAY = 1.5
D_FF = 2816
REL_BUCKETS = 32
REL_MAX_DIST = 128
Q_BLOCK = 128
RMS_EPS = 1e-6

kernel_name = "hymba_diffattn_hyena_macaron_encoder"

F32 = jnp.float32


def rmsnorm(x, g):
    xf = x.astype(F32)
    y = xf * lax.rsqrt(jnp.mean(xf * xf, axis=-1, keepdims=True) + RMS_EPS)
    return (y * g.astype(F32)).astype(x.dtype)


def swiglu(x, w_gate, w_up, w_down):
    return (jax.nn.silu(x @ w_gate) * (x @ w_up)) @ w_down


def t5_bucket(rel):
    half = REL_BUCKETS // 2
    max_exact = half // 2
    ret = jnp.where(rel > 0, half, 0)
    n = jnp.abs(rel)
    nf = jnp.maximum(n, 1).astype(F32)
    large = max_exact + (jnp.log(nf / max_exact) / math.log(REL_MAX_DIST / max_exact)
                         * (half - max_exact)).astype(jnp.int32)
    large = jnp.minimum(large, half - 1)
    return ret + jnp.where(n < max_exact, n, large)


def diff_attention(q, k, v, lam, lambda_init, subln_g, rel_table):
    B, S = q.shape[0], q.shape[1]
    nblk = S // Q_BLOCK
    qb = q.reshape(B, nblk, Q_BLOCK, N_DIFF_HEADS, 2, DIFF_HEAD_DIM).swapaxes(0, 1)
    kpos = jnp.arange(S, dtype=jnp.int32)
    scale = DIFF_HEAD_DIM ** -0.5

    def block(args):
        qblk, start = args
        qpos = start + jnp.arange(Q_BLOCK, dtype=jnp.int32)
        bucket = t5_bucket(kpos[None, :] - qpos[:, None])
        bias = jnp.take(rel_table, bucket, axis=0).transpose(2, 0, 1).astype(F32)
        logits = jnp.einsum('bqhcd,bkhcd->bhcqk', qblk, k,
                            preferred_element_type=F32) * scale + bias[None, :, None]
        p = jax.nn.softmax(logits, axis=-1)
        attn = p[:, :, 0] - lam * p[:, :, 1]
        return jnp.einsum('bhqk,bkhe->bqhe', attn.astype(v.dtype), v)

    starts = jnp.arange(nblk, dtype=jnp.int32) * Q_BLOCK
    out = lax.map(block, (qb, starts))
    out = out.swapaxes(0, 1).reshape(B, S, N_DIFF_HEADS, V_HEAD_DIM)
    out = rmsnorm(out, subln_g) * (1.0 - lambda_init)
    return out.reshape(B, S, N_DIFF_HEADS * V_HEAD_DIM)


def hyena_filters(L, w1, b1, w2, b2, w3, b3, w4, freq):
    t = jnp.linspace(0.0, 1.0, L, dtype=F32)[:, None]
    bands = (HYENA_EMB_DIM - 1) // 2
    w = 2.0 * math.pi * jnp.arange(L, dtype=F32)[:, None] / L
    f = jnp.linspace(1e-4, bands - 1, bands, dtype=F32)[None, :]
    fw = f * w
    z = jnp.concatenate([t, jnp.cos(fw), -jnp.sin(fw)], axis=-1)
    fr = freq.astype(F32)
    a = jnp.sin(fr * (z @ w1.astype(F32) + b1.astype(F32)))
    a = jnp.sin(fr * (a @ w2.astype(F32) + b2.astype(F32)))
    a = jnp.sin(fr * (a @ w3.astype(F32) + b3.astype(F32)))
    h = a @ w4.astype(F32)
    max_decay = math.log(HYENA_DECAY_TARGET) / HYENA_FAST_DECAY
    min_decay = math.log(HYENA_DECAY_TARGET) / HYENA_SLOW_DECAY
    deltas = jnp.linspace(min_decay, max_decay, D_HYENA, dtype=F32)
    decay = jnp.exp(-t * jnp.abs(deltas)[None, :])
    h = h.reshape(L, 2, D_HYENA) * decay[:, None, :]
    return h[:, 0], h[:, 1]


def bidirectional_fftconv(u, h_fwd, h_bwd):
    L = u.shape[1]
    n = 2 * L
    kern = jnp.concatenate([h_fwd, jnp.zeros((1, h_fwd.shape[1]), F32), h_bwd[1:][::-1]], axis=0)
    uf = jnp.fft.rfft(u.astype(F32), n=n, axis=1)
    kf = jnp.fft.rfft(kern, n=n, axis=0)
    y = jnp.fft.irfft(uf * kf[None], n=n, axis=1)[:, :L]
    return y.astype(u.dtype)


def short_conv(u, w, b):
    S = u.shape[1]
    pad = HYENA_SHORT_CONV // 2
    up = jnp.pad(u, ((0, 0), (pad, HYENA_SHORT_CONV - 1 - pad), (0, 0)))
    out = b
    for i in range(HYENA_SHORT_CONV):
        out = out + up[:, i:i + S] * w[i]
    return out


def hyena(z, conv_w, conv_b, f_w1, f_b1, f_w2, f_b2, f_w3, f_b3, f_w4, f_freq, filt_bias, out_g):
    B, S = z.shape[0], z.shape[1]
    u = short_conv(z, conv_w, conv_b)
    x0, x1, v = jnp.split(u, 3, axis=-1)
    h_fwd, h_bwd = hyena_filters(S, f_w1, f_b1, f_w2, f_b2, f_w3, f_b3, f_w4, f_freq)
    v = v * x1
    v = bidirectional_fftconv(v, h_fwd, h_bwd) + v * filt_bias
    y = v * x0
    y = rmsnorm(y.reshape(B, S, N_HYENA_GROUPS, HYENA_GROUP_DIM),
                out_g.reshape(N_HYENA_GROUPS, HYENA_GROUP_DIM))
    return y.reshape(B, S, D_HYENA)


def setup_inputs(seed: int = 0) -> dict:
    key = jax.random.key(seed)
    ks = iter(jax.random.split(key, 48))

    def nrm(shape, scale):
        return jax.random.normal(next(ks), shape, F32) * scale

    def gain(shape):
        return 1.0 + nrm(shape, 0.02)

    D, L, FO, E = D_MODEL, DEPTH, HYENA_FILTER_ORDER, HYENA_EMB_DIM
    return {
        "x": nrm((BATCH, SEQ, D), 1.0),
        "rel_bias": nrm((REL_BUCKETS, N_DIFF_HEADS), 0.2),
        "ffn1_norm": gain((L, D)),
        "ffn1_w_gate": nrm((L, D, D_FF), D ** -0.5),
        "ffn1_w_up": nrm((L, D, D_FF), D ** -0.5),
        "ffn1_w_down": nrm((L, D_FF, D), D_FF ** -0.5),
        "mix_norm": gain((L, D)),
        "w_in": nrm((L, D, D_IN), D ** -0.5),
        "lambda_q1": nrm((L, DIFF_HEAD_DIM), 0.1),
        "lambda_k1": nrm((L, DIFF_HEAD_DIM), 0.1),
        "lambda_q2": nrm((L, DIFF_HEAD_DIM), 0.1),
        "lambda_k2": nrm((L, DIFF_HEAD_DIM), 0.1),
        "diff_subln": gain((L, V_HEAD_DIM)),
        "hy_conv_w": nrm((L, HYENA_SHORT_CONV, 3 * D_HYENA), HYENA_SHORT_CONV ** -0.5),
        "hy_conv_b": nrm((L, 3 * D_HYENA), 0.02),
        "hy_f_w1": nrm((L, E, FO), E ** -0.5),
        "hy_f_b1": nrm((L, FO), 0.02),
        "hy_f_w2": nrm((L, FO, FO), FO ** -0.5),
        "hy_f_b2": nrm((L, FO), 0.02),
        "hy_f_w3": nrm((L, FO, FO), FO ** -0.5),
        "hy_f_b3": nrm((L, FO), 0.02),
        "hy_f_w4": nrm((L, FO, 2 * D_HYENA), FO ** -0.5),
        "hy_f_freq": gain((L, FO)),
        "hy_bias": nrm((L, D_HYENA), 1.0),
        "hy_out_norm": gain((L, D_HYENA)),
        "w_out": nrm((L, D_MIX, D), D_MIX ** -0.5),
        "ffn2_norm": gain((L, D)),
        "ffn2_w_gate": nrm((L, D, D_FF), D ** -0.5),
        "ffn2_w_up": nrm((L, D, D_FF), D ** -0.5),
        "ffn2_w_down": nrm((L, D_FF, D), D_FF ** -0.5),
        "final_norm": gain((D,)),
    }


def reference(x, rel_bias, ffn1_norm, ffn1_w_gate, ffn1_w_up, ffn1_w_down, mix_norm, w_in,
              lambda_q1, lambda_k1, lambda_q2, lambda_k2, diff_subln,
              hy_conv_w, hy_conv_b, hy_f_w1, hy_f_b1, hy_f_w2, hy_f_b2, hy_f_w3, hy_f_b3,
              hy_f_w4, hy_f_freq, hy_bias, hy_out_norm, w_out,
              ffn2_norm, ffn2_w_gate, ffn2_w_up, ffn2_w_down, final_norm):
    B, S = x.shape[0], x.shape[1]
    for l in range(DEPTH):
        x = x + 0.5 * swiglu(rmsnorm(x, ffn1_norm[l]), ffn1_w_gate[l], ffn1_w_up[l], ffn1_w_down[l])

        h = rmsnorm(x, mix_norm[l])
        p = h @ w_in[l]
        q = p[..., :D_ATT].reshape(B, S, N_DIFF_HEADS, 2, DIFF_HEAD_DIM)
        k = p[..., D_ATT:2 * D_ATT].reshape(B, S, N_DIFF_HEADS, 2, DIFF_HEAD_DIM)
        v = p[..., 2 * D_ATT:3 * D_ATT].reshape(B, S, N_DIFF_HEADS, V_HEAD_DIM)
        z_hy = p[..., 3 * D_ATT:]

        lambda_init = 0.8 - 0.6 * math.exp(-0.3 * l)
        lam = (jnp.exp(jnp.sum((lambda_q1[l] * lambda_k1[l]).astype(F32)))
               - jnp.exp(jnp.sum((lambda_q2[l] * lambda_k2[l]).astype(F32)))
               + lambda_init)
        att_out = diff_attention(q, k, v, lam, lambda_init, diff_subln[l], rel_bias)
        hy_out = hyena(z_hy, hy_conv_w[l], hy_conv_b[l], hy_f_w1[l], hy_f_b1[l], hy_f_w2[l],
                       hy_f_b2[l], hy_f_w3[l], hy_f_b3[l], hy_f_w4[l], hy_f_freq[l],
                       hy_bias[l], hy_out_norm[l])
        x = x + jnp.concatenate([att_out, hy_out], axis=-1) @ w_out[l]

        x = x + 0.5 * swiglu(rmsnorm(x, ffn2_norm[l]), ffn2_w_gate[l], ffn2_w_up[l], ffn2_w_down[l])
    return rmsnorm(x, final_norm)
```

```cpp
#include <hip/hip_runtime.h>
#include <cstdio>
#include <cstdint>
#include <cmath>

typedef unsigned short bf16;
typedef short bf16x8 __attribute__((ext_vector_type(8)));
typedef float f32x4 __attribute__((ext_vector_type(4)));

constexpr int BATCH = 2, SEQ = 8192, D = 1024, M = BATCH * SEQ, FF = 2816, DIN = 3072;
constexpr int DATT = 512, DHY = 512, NH = 4;
constexpr float EPS = 1e-6f;
constexpr float LOG2E = 1.4426950408889634f;
constexpr float C2 = 0.125f * LOG2E;

constexpr size_t MiB = 1u << 20;
constexpr size_t WS_CTL = 0;
constexpr size_t WS_WGU1 = 1 * MiB;
constexpr size_t WS_WD1 = 12 * MiB;
constexpr size_t WS_WIN = 18 * MiB;
constexpr size_t WS_WOUT = 24 * MiB;
constexpr size_t WS_WGU2 = 26 * MiB;
constexpr size_t WS_WD2 = 37 * MiB;
constexpr size_t WS_SSQ = 43 * MiB;
constexpr size_t WS_A3 = 43 * MiB + 512 * 1024;
constexpr size_t WS_G = 46 * MiB;
constexpr size_t WS_XB = 62 * MiB;
constexpr size_t WS_X1 = 94 * MiB;
constexpr size_t WS_H = 158 * MiB;
constexpr size_t WS_Q = WS_H, WS_K = WS_H + 16 * MiB, WS_V = WS_H + 32 * MiB;
constexpr size_t WS_A2 = WS_H + 48 * MiB;
constexpr size_t WS_END = 246 * MiB;
constexpr size_t DO_ZT = 0, DO_YT = 48 * MiB;

__device__ __forceinline__ unsigned f2bf(float f) { unsigned u = __builtin_bit_cast(unsigned, f); return (u + 0x7fffu + ((u >> 16) & 1u)) >> 16; }
__device__ __forceinline__ float bf2f(bf16 b) { return __builtin_bit_cast(float, (unsigned)b << 16); }

__global__ void k_wconv(const float* __restrict__ W, const float* __restrict__ W2, const float* __restrict__ gain, bf16* __restrict__ Wt, int K, int N, int mode) {
    const int n = blockIdx.x * 256 + threadIdx.x; const int k = blockIdx.y;
    if (n >= N) return;
    const float g = gain ? gain[k] : 1.f;
    if (mode == 0) { Wt[(size_t)n * K + k] = (bf16)f2bf(W[(size_t)k * N + n] * g); }
    else { const int np = 256 * (n / 128) + (n % 128);
        Wt[(size_t)np * K + k] = (bf16)f2bf(W[(size_t)k * N + n] * g);
        Wt[(size_t)(np + 128) * K + k] = (bf16)f2bf(W2[(size_t)k * N + n] * g); }
}

__global__ void k_rowstats(const float* __restrict__ X, bf16* __restrict__ XB, float* __restrict__ ssq) {
    const int wave = (blockIdx.x * blockDim.x + threadIdx.x) >> 6, lane = threadIdx.x & 63;
    if (wave >= M) return;
    const float* xr = X + (size_t)wave * D;
    _Pragma("unroll") for (int p = 0; p < 4; ++p) {
        const f32x4 v = *(const f32x4*)(xr + p * 256 + lane * 4);
        float s = v.x * v.x + v.y * v.y + v.z * v.z + v.w * v.w;
        _Pragma("unroll") for (int o = 1; o < 64; o <<= 1) s += __shfl_xor(s, o);
        if (lane == 0) ssq[(size_t)wave * 4 + p] = s;
        unsigned lo = f2bf(v.x) | (f2bf(v.y) << 16), hi = f2bf(v.z) | (f2bf(v.w) << 16);
        *(uint2*)(XB + (size_t)wave * D + p * 256 + lane * 4) = make_uint2(lo, hi);
    }
}

__device__ __forceinline__ float rstd_of(const float* ssq, int row) { const f32x4 s = *(const f32x4*)(ssq + (size_t)row * 4); return rsqrtf((s.x + s.y + s.z + s.w) * (1.f / D) + EPS); }

struct EpiUp { bf16* H; const float* ssq; };
struct EpiDown { const float* Xin; float* Xout; float scale; };
struct EpiIn { bf16* Q; bf16* K; bf16* V; bf16* ZT; const float* ssq; };

template <int MODE  >
__global__ void __launch_bounds__(256) k_gemm(const bf16* __restrict__ A, const bf16* __restrict__ Bt, int Kd, int Ncols, EpiUp e0, EpiDown e1, EpiIn e2) {
    const int wave = threadIdx.x >> 6, lane = threadIdx.x & 63, fr = lane & 15, fq = lane >> 4;
    const int m0 = blockIdx.y * 64 + (wave >> 1) * 32, n0 = blockIdx.x * 64 + (wave & 1) * 32;
    f32x4 acc[2][2], acc2[2][2];
    _Pragma("unroll") for (int i = 0; i < 2; ++i) _Pragma("unroll") for (int j = 0; j < 2; ++j) { acc[i][j] = (f32x4){0.f, 0.f, 0.f, 0.f}; acc2[i][j] = (f32x4){0.f, 0.f, 0.f, 0.f}; }
    int nb0 = n0;
    if (MODE == 0) nb0 = 256 * (n0 / 128) + (n0 % 128);
    for (int k0 = 0; k0 < Kd; k0 += 32) {
        bf16x8 a[2], b[2], b2[2];
        _Pragma("unroll") for (int i = 0; i < 2; ++i) a[i] = *(const bf16x8*)(A + (size_t)(m0 + i * 16 + fr) * Kd + k0 + fq * 8);
        _Pragma("unroll") for (int j = 0; j < 2; ++j) { b[j] = *(const bf16x8*)(Bt + (size_t)(nb0 + j * 16 + fr) * Kd + k0 + fq * 8);
            if (MODE == 0) b2[j] = *(const bf16x8*)(Bt + (size_t)(nb0 + 128 + j * 16 + fr) * Kd + k0 + fq * 8); }
        _Pragma("unroll") for (int i = 0; i < 2; ++i) _Pragma("unroll") for (int j = 0; j < 2; ++j) {
            acc[i][j] = __builtin_amdgcn_mfma_f32_16x16x32_bf16(a[i], b[j], acc[i][j], 0, 0, 0);
            if (MODE == 0) acc2[i][j] = __builtin_amdgcn_mfma_f32_16x16x32_bf16(a[i], b2[j], acc2[i][j], 0, 0, 0); }
    }
    _Pragma("unroll") for (int i = 0; i < 2; ++i) _Pragma("unroll") for (int r = 0; r < 4; ++r) {
        const int row = m0 + 16 * i + 4 * fq + r;
        _Pragma("unroll") for (int j = 0; j < 2; ++j) {
            const int col = n0 + 16 * j + fr; const float v = acc[i][j][r];
            if (MODE == 0) { const float rs = rstd_of(e0.ssq, row); const float g = v * rs, u = acc2[i][j][r] * rs;
                e0.H[(size_t)row * FF + col] = (bf16)f2bf(g / (1.f + __expf(-g)) * u); }
            else if (MODE == 1) { const size_t o = (size_t)row * Ncols + col; e1.Xout[o] = e1.Xin[o] + e1.scale * v; }
            else { const float rs = rstd_of(e2.ssq, row); const float p = v * rs;
                if (col < 512) e2.Q[(size_t)row * 512 + col] = (bf16)f2bf(p * C2);
                else if (col < 1024) e2.K[(size_t)row * 512 + col - 512] = (bf16)f2bf(p);
                else if (col < 1536) e2.V[(size_t)row * 512 + col - 1024] = (bf16)f2bf(p);
                else e2.ZT[(size_t)(col - 1536) * M + row] = (bf16)f2bf(p); }
        }
    }
}

__device__ __forceinline__ int t5_bucket(int rel) {
    const int n = rel < 0 ? -rel : rel; int b;
    if (n < 8) b = n; else if (n < 12) b = 8; else if (n < 16) b = 9; else if (n < 23) b = 10; else if (n < 32) b = 11;
    else if (n < 46) b = 12; else if (n < 64) b = 13; else if (n < 91) b = 14; else b = 15;
    return b + (rel > 0 ? 16 : 0);
}

__global__ void __launch_bounds__(256) k_attn_simple(const bf16* __restrict__ Q, const bf16* __restrict__ K, const bf16* __restrict__ V, const float* __restrict__ rel_bias,
                                                      const float* lq1, const float* lk1, const float* lq2, const float* lk2, const float* subln, bf16* __restrict__ A2) {
    __shared__ float Ks[32][128]; __shared__ float Vs[32][128]; __shared__ float btab[257]; __shared__ float lam_s;
    const int tid = threadIdx.x, part = tid & 3, ql = tid >> 2;
    const int qblk = blockIdx.x & 127, h = (blockIdx.x >> 7) & 3, b = blockIdx.x >> 9;
    const int qpos = qblk * 64 + ql; const size_t mrow = (size_t)b * SEQ + qpos;
    for (int i = tid; i < 257; i += 256) btab[i] = rel_bias[t5_bucket(i - 128) * NH + h] * LOG2E;
    if (tid == 0) { float s1 = 0.f, s2 = 0.f; for (int i = 0; i < 64; ++i) { s1 += lq1[i] * lk1[i]; s2 += lq2[i] * lk2[i]; } lam_s = expf(s1) - expf(s2) + 0.2f; }
    float q1[16], q2[16];
    _Pragma("unroll") for (int d = 0; d < 16; ++d) { q1[d] = bf2f(Q[mrow * 512 + h * 128 + part * 16 + d]); q2[d] = bf2f(Q[mrow * 512 + h * 128 + 64 + part * 16 + d]); }
    float o1[32], o2[32]; _Pragma("unroll") for (int e = 0; e < 32; ++e) { o1[e] = 0.f; o2[e] = 0.f; }
    float m1 = -1e30f, m2 = -1e30f, l1 = 0.f, l2 = 0.f;
    for (int k0 = 0; k0 < SEQ; k0 += 32) {
        __syncthreads();
        for (int i = tid; i < 32 * 128; i += 256) { const int kk = i >> 7, c = i & 127; const size_t kr = (size_t)b * SEQ + k0 + kk;
            Ks[kk][c] = bf2f(K[kr * 512 + h * 128 + c]); Vs[kk][c] = bf2f(V[kr * 512 + h * 128 + c]); }
        __syncthreads();
        float s1[32], s2[32]; float t1 = -1e30f, t2 = -1e30f;
        _Pragma("unroll") for (int j = 0; j < 32; ++j) { float a = 0.f, c = 0.f;
            _Pragma("unroll") for (int d = 0; d < 16; ++d) { a += q1[d] * Ks[j][part * 16 + d]; c += q2[d] * Ks[j][64 + part * 16 + d]; }
            a += __shfl_xor(a, 1); a += __shfl_xor(a, 2); c += __shfl_xor(c, 1); c += __shfl_xor(c, 2);
            int rel = k0 + j - qpos; rel = rel < -128 ? -128 : (rel > 128 ? 128 : rel); const float bb = btab[rel + 128];
            a += bb; c += bb; s1[j] = a; s2[j] = c; t1 = fmaxf(t1, a); t2 = fmaxf(t2, c); }
        const float n1 = fmaxf(m1, t1), n2 = fmaxf(m2, t2); const float a1 = exp2f(m1 - n1), a2 = exp2f(m2 - n2);
        m1 = n1; m2 = n2; l1 *= a1; l2 *= a2;
        _Pragma("unroll") for (int e = 0; e < 32; ++e) { o1[e] *= a1; o2[e] *= a2; }
        _Pragma("unroll") for (int j = 0; j < 32; ++j) { const float p1 = exp2f(s1[j] - m1), p2 = exp2f(s2[j] - m2); l1 += p1; l2 += p2;
            _Pragma("unroll") for (int e = 0; e < 32; ++e) { const float v = Vs[j][part * 32 + e]; o1[e] += p1 * v; o2[e] += p2 * v; } }
    }
    const float lam = lam_s; const float i1 = 1.f / l1, i2 = lam / l2; float ss = 0.f;
    _Pragma("unroll") for (int e = 0; e < 32; ++e) { o1[e] = o1[e] * i1 - o2[e] * i2; ss += o1[e] * o1[e]; }
    ss += __shfl_xor(ss, 1); ss += __shfl_xor(ss, 2);
    const float rs = rsqrtf(ss * (1.f / 128.f) + EPS) * 0.8f;
    _Pragma("unroll") for (int e = 0; e < 32; ++e) A2[mrow * D + h * 128 + part * 32 + e] = (bf16)f2bf(o1[e] * rs * subln[part * 32 + e]);
}

__global__ void k_filt_mlp(const float* w1, const float* b1, const float* w2, const float* b2, const float* w3, const float* b3, const float* freq, float* __restrict__ A3) {
    __shared__ float z[33], a1[64], a2[64];
    const int i = blockIdx.x, j = threadIdx.x;
    if (j == 0) z[0] = (float)i / (float)(SEQ - 1);
    if (j < 16) { const float w = (6.283185307179586f * (float)i) / (float)SEQ; const float f = 1e-4f + (float)j * ((15.0f - 1e-4f) / 15.0f); const float fw = f * w;
        z[1 + j] = cosf(fw); z[17 + j] = -sinf(fw); }
    __syncthreads();
    const float fr = freq[j];
    { float s = b1[j]; for (int e = 0; e < 33; ++e) s += z[e] * w1[e * 64 + j]; a1[j] = sinf(fr * s); }
    __syncthreads();
    { float s = b2[j]; for (int e = 0; e < 64; ++e) s += a1[e] * w2[e * 64 + j]; a2[j] = sinf(fr * s); }
    __syncthreads();
    { float s = b3[j]; for (int e = 0; e < 64; ++e) s += a2[e] * w3[e * 64 + j]; A3[(size_t)i * 64 + j] = sinf(fr * s); }
}
__global__ void k_filt_out(const float* __restrict__ A3, const float* __restrict__ w4, bf16* __restrict__ G) {
    const int col = blockIdx.x * 256 + threadIdx.x, i = blockIdx.y;
    float s = 0.f; for (int k = 0; k < 64; ++k) s += A3[(size_t)i * 64 + k] * w4[k * 1024 + col];
    const int dir = col >> 9, c = col & 511;
    const float mind = logf(1e-2f) / 1.5f, maxd = logf(1e-2f) / 0.3f;
    const float delta = mind + (float)c * ((maxd - mind) / 511.0f);
    const float t = (float)i / (float)(SEQ - 1);
    const float val = s * expf(-t * fabsf(delta));
    if (dir == 0) G[(size_t)c * 16384 + 8192 + i] = (bf16)f2bf(val);
    else { if (i >= 1) G[(size_t)c * 16384 + 8192 - i] = (bf16)f2bf(val); else G[(size_t)c * 16384] = 0; }
}

__global__ void __launch_bounds__(256) k_hy_pre(bf16* __restrict__ ZT, const float* __restrict__ cw, const float* __restrict__ cb) {
    extern __shared__ float zs[];
    bf16* zb = (bf16*)zs;
    const int c = blockIdx.x, tid = threadIdx.x;
    _Pragma("unroll") for (int r = 0; r < 3; ++r) for (int i = tid; i < M / 8; i += 256) ((uint4*)(zb + (size_t)r * M))[i] = ((const uint4*)(ZT + (size_t)(r * 512 + c) * M))[i];
    __syncthreads();
    float w[3][3], bb[3];
    _Pragma("unroll") for (int r = 0; r < 3; ++r) { bb[r] = cb[r * 512 + c]; _Pragma("unroll") for (int i = 0; i < 3; ++i) w[r][i] = cw[i * 1536 + r * 512 + c]; }
    for (int m = tid; m < M; m += 256) { const int t = m & (SEQ - 1); float u[3];
        _Pragma("unroll") for (int r = 0; r < 3; ++r) { const bf16* zr = zb + (size_t)r * M;
            const float zm = t > 0 ? bf2f(zr[m - 1]) : 0.f, z0 = bf2f(zr[m]), zp = t < SEQ - 1 ? bf2f(zr[m + 1]) : 0.f;
            u[r] = bb[r] + w[r][0] * zm + w[r][1] * z0 + w[r][2] * zp; }
        ZT[(size_t)c * M + m] = (bf16)f2bf(u[0]); ZT[(size_t)(512 + c) * M + m] = (bf16)f2bf(u[2] * u[1]); }
}
__global__ void __launch_bounds__(256) k_conv_simple(const bf16* __restrict__ ZT, const bf16* __restrict__ G, const float* __restrict__ hbias, bf16* __restrict__ YT) {
    __shared__ float us[256]; __shared__ float gs[1280];
    const int tid = threadIdx.x, tc = blockIdx.x & 7, b = (blockIdx.x >> 3) & 1, c = blockIdx.x >> 4;
    const int t0 = tc * 1024; const bf16* U = ZT + (size_t)(512 + c) * M + (size_t)b * SEQ; const bf16* g = G + (size_t)c * 16384 + 8192;
    float acc[4] = {0.f, 0.f, 0.f, 0.f};
    for (int s0 = 0; s0 < SEQ; s0 += 256) {
        __syncthreads();
        us[tid] = bf2f(U[s0 + tid]);
        for (int i = tid; i < 1279; i += 256) { const int d = t0 - s0 - 255 + i; gs[i] = (d > -8192 && d < 8192) ? bf2f(g[d]) : 0.f; }
        __syncthreads();
        _Pragma("unroll 8") for (int sl = 0; sl < 256; ++sl) { const float u = us[sl];
            _Pragma("unroll") for (int j = 0; j < 4; ++j) acc[j] += gs[tid + 256 * j - sl + 255] * u; }
    }
    const float hb = hbias[c];
    _Pragma("unroll") for (int j = 0; j < 4; ++j) { const size_t m = (size_t)b * SEQ + t0 + tid + 256 * j;
        const float vx = bf2f(ZT[(size_t)(512 + c) * M + m]), x0 = bf2f(ZT[(size_t)c * M + m]);
        YT[(size_t)c * M + m] = (bf16)f2bf((acc[j] + vx * hb) * x0); }
}
__global__ void k_hy_norm(const bf16* __restrict__ YT, const float* __restrict__ og, bf16* __restrict__ A2) {
    const int m = blockIdx.x * 256 + threadIdx.x, g = blockIdx.y;
    float y[64]; float ss = 0.f;
    _Pragma("unroll") for (int ch = 0; ch < 64; ++ch) { y[ch] = bf2f(YT[(size_t)(g * 64 + ch) * M + m]); ss += y[ch] * y[ch]; }
    const float rs = rsqrtf(ss * (1.f / 64.f) + EPS);
    _Pragma("unroll") for (int ch = 0; ch < 64; ++ch) A2[(size_t)m * D + 512 + g * 64 + ch] = (bf16)f2bf(y[ch] * rs * og[g * 64 + ch]);
}
__global__ void k_final_norm(const float* X, const float* __restrict__ gain, float* out) {
    const int wave = (blockIdx.x * blockDim.x + threadIdx.x) >> 6, lane = threadIdx.x & 63;
    if (wave >= M) return;
    f32x4 v[4]; float s = 0.f;
    _Pragma("unroll") for (int p = 0; p < 4; ++p) { v[p] = *(const f32x4*)(X + (size_t)wave * D + p * 256 + lane * 4); s += v[p].x * v[p].x + v[p].y * v[p].y + v[p].z * v[p].z + v[p].w * v[p].w; }
    _Pragma("unroll") for (int o = 1; o < 64; o <<= 1) s += __shfl_xor(s, o);
    const float rs = rsqrtf(s * (1.f / D) + EPS);
    _Pragma("unroll") for (int p = 0; p < 4; ++p) { const f32x4 g = *(const f32x4*)(gain + p * 256 + lane * 4);
        *(f32x4*)(out + (size_t)wave * D + p * 256 + lane * 4) = (f32x4){v[p].x * rs * g.x, v[p].y * rs * g.y, v[p].z * rs * g.z, v[p].w * rs * g.w}; }
}

extern "C" void kernel_launch(void* const* d_in, const int* in_sizes, int n_in, void* d_out, int out_size, void* d_ws, size_t ws_size, hipStream_t stream) {
    if (n_in != 31 || ws_size < WS_END) { fprintf(stderr, "kernel_launch: unexpected n_in %d / ws %zu\n", n_in, ws_size); return; }
    auto F = [&](int i) { return (const float*)d_in[i]; };
    unsigned char* ws = (unsigned char*)d_ws; unsigned char* dob = (unsigned char*)d_out;
    bf16 *Wgu1 = (bf16*)(ws + WS_WGU1), *Wd1 = (bf16*)(ws + WS_WD1), *Win = (bf16*)(ws + WS_WIN), *Wout = (bf16*)(ws + WS_WOUT), *Wgu2 = (bf16*)(ws + WS_WGU2), *Wd2 = (bf16*)(ws + WS_WD2);
    float* ssq = (float*)(ws + WS_SSQ); float* A3 = (float*)(ws + WS_A3); bf16* G = (bf16*)(ws + WS_G);
    bf16* XB = (bf16*)(ws + WS_XB); float* X1 = (float*)(ws + WS_X1); bf16* H = (bf16*)(ws + WS_H);
    bf16 *Qb = (bf16*)(ws + WS_Q), *Kb = (bf16*)(ws + WS_K), *Vb = (bf16*)(ws + WS_V), *A2 = (bf16*)(ws + WS_A2);
    bf16* ZT = (bf16*)(dob + DO_ZT); bf16* YT = (bf16*)(dob + DO_YT);
    float* out = (float*)d_out;
    k_wconv<<<dim3(FF / 256, D), 256, 0, stream>>>(F(3), F(4), F(2), Wgu1, D, FF, 1);
    k_wconv<<<dim3(D / 256, FF), 256, 0, stream>>>(F(5), nullptr, nullptr, Wd1, FF, D, 0);
    k_wconv<<<dim3(DIN / 256, D), 256, 0, stream>>>(F(7), nullptr, F(6), Win, D, DIN, 0);
    k_wconv<<<dim3(D / 256, D), 256, 0, stream>>>(F(25), nullptr, nullptr, Wout, D, D, 0);
    k_wconv<<<dim3(FF / 256, D), 256, 0, stream>>>(F(27), F(28), F(26), Wgu2, D, FF, 1);
    k_wconv<<<dim3(D / 256, FF), 256, 0, stream>>>(F(29), nullptr, nullptr, Wd2, FF, D, 0);
    k_filt_mlp<<<SEQ, 64, 0, stream>>>(F(15), F(16), F(17), F(18), F(19), F(20), F(22), A3);
    k_filt_out<<<dim3(4, SEQ), 256, 0, stream>>>(A3, F(21), G);
    k_rowstats<<<M / 4, 256, 0, stream>>>(F(0), XB, ssq);
    EpiUp e0{}; EpiDown e1{}; EpiIn e2{};
    e0 = EpiUp{H, ssq};
    k_gemm<0><<<dim3(FF / 64, M / 64), 256, 0, stream>>>(XB, Wgu1, D, FF, e0, e1, e2);
    e1 = EpiDown{F(0), X1, 0.5f};
    k_gemm<1><<<dim3(D / 64, M / 64), 256, 0, stream>>>(H, Wd1, FF, D, e0, e1, e2);
    k_rowstats<<<M / 4, 256, 0, stream>>>(X1, XB, ssq);
    e2 = EpiIn{Qb, Kb, Vb, ZT, ssq};
    k_gemm<2><<<dim3(DIN / 64, M / 64), 256, 0, stream>>>(XB, Win, D, DIN, e0, e1, e2);
    k_attn_simple<<<BATCH * NH * (SEQ / 64), 256, 0, stream>>>(Qb, Kb, Vb, F(1), F(8), F(9), F(10), F(11), F(12), A2);
    hipFuncSetAttribute((const void*)k_hy_pre, hipFuncAttributeMaxDynamicSharedMemorySize, 3 * M * 2);
    k_hy_pre<<<512, 256, 3 * M * 2, stream>>>(ZT, F(13), F(14));
    k_conv_simple<<<512 * 2 * 8, 256, 0, stream>>>(ZT, G, F(23), YT);
    k_hy_norm<<<dim3(M / 256, 8), 256, 0, stream>>>(YT, F(24), A2);
    e1 = EpiDown{X1, X1, 1.0f};
    k_gemm<1><<<dim3(D / 64, M / 64), 256, 0, stream>>>(A2, Wout, D, D, e0, e1, e2);
    k_rowstats<<<M / 4, 256, 0, stream>>>(X1, XB, ssq);
    e0 = EpiUp{H, ssq};
    k_gemm<0><<<dim3(FF / 64, M / 64), 256, 0, stream>>>(XB, Wgu2, D, FF, e0, e1, e2);
    e1 = EpiDown{X1, out, 0.5f};
    k_gemm<1><<<dim3(D / 64, M / 64), 256, 0, stream>>>(H, Wd2, FF, D, e0, e1, e2);
    k_final_norm<<<M / 4, 256, 0, stream>>>(out, F(30), out);
}
```

```cpp
#include <hip/hip_runtime.h>
#include <cstdio>
#include <cstdint>
#include <cmath>
namespace pg8 {
#define PG8_LAS __attribute__((address_space(3)))
typedef unsigned short bf16_t;
typedef short bf16x8 __attribute__((ext_vector_type(8)));
typedef float f32x4 __attribute__((ext_vector_type(4)));
typedef unsigned u32x4 __attribute__((ext_vector_type(4)));
constexpr int BM = 256, BK = 64, HALF = 128, HTB = HALF * BK * 2  , STAGE_BYTES = 8 * HTB, NXCD = 8, WGM = 8;

__host__ __device__ __forceinline__ int lds_byte(int r, int c) { const int st = (r >> 4) * 2 + (c >> 5), rr = r & 15, cc = c & 31, ob = rr * 64 + cc * 2; return st * 1024 + (ob ^ (((ob >> 9) & 1) << 5)); }
__host__ __device__ __forceinline__ void stage_rc(int b, int& R, int& C) { const int st = b / 1024, sb = b % 1024, swz = sb ^ (((sb >> 9) & 1) << 5); R = (st >> 1) * 16 + swz / 64; C = (st & 1) * 32 + (swz % 64) / 2; }
__host__ __device__ __forceinline__ int perm32(int rho) { const int n = rho >> 4, i = rho & 15; return 8 * (i >> 2) + 4 * n + (i & 3); }

struct Unit { int pm, pn; };
struct Gemm { const bf16_t* A; const bf16_t* Bt; int M, N, K; };

struct StaticOrder {
    int nM, nN, nwg, G, c;
    __host__ __device__ void init(int M, int N, int G_, int c_) { nM = M / BM; nN = N / BM; nwg = nM * nN; G = G_; c = c_; }
    __host__ __device__ bool next(int i, Unit& u) const {
        const long L = (long)i * G + c; if (L >= nwg) return false;
        int wgid = (int)L; { const int q = nwg / NXCD, r = nwg % NXCD, xcd = wgid % NXCD, off = wgid / NXCD; wgid = (xcd < r ? xcd * (q + 1) : r * (q + 1) + (xcd - r) * q) + off; }
        const int nig = WGM * nN, gid = wgid / nig, fm = gid * WGM, gsz = (nM - fm) < WGM ? (nM - fm) : WGM;
        u.pm = fm + ((wgid % nig) % gsz); u.pn = (wgid % nig) / gsz; return true;
    }
    __device__ __forceinline__ void a_ready(const Unit&) const {}
    __device__ __forceinline__ void done(const Unit&) const {}
};

__device__ __forceinline__ unsigned cvt_pk_bf16(float lo, float hi) { unsigned r; asm volatile("v_cvt_pk_bf16_f32 %0, %1, %2" : "=v"(r) : "v"(lo), "v"(hi)); return r; }
constexpr float RMS_EPS = 1e-6f;
__device__ __forceinline__ float rstd_row(const float* ssq, int row) { const f32x4 s = *(const f32x4*)(ssq + (size_t)row * 4); return __builtin_amdgcn_rsqf(((s[0] + s[1]) + (s[2] + s[3])) * (1.0f / 1024.0f) + RMS_EPS); }
__device__ __forceinline__ float silu_mul(float g, float u) { return g * __builtin_amdgcn_rcpf(1.0f + __builtin_amdgcn_exp2f(-1.4426950408889634f * g)) * u; }

struct EpiSwiglu {
    static constexpr bool PERM = true, AFTER_DRAIN = false;
    bf16_t* H; int ldh; const float* ssq;
    __device__ __forceinline__ void operator()(const f32x4 (&acc)[2][2][4][2], const Unit& u, int wr, int wc, int fr, int fq) const {
        const int row0 = u.pm * BM + wr * 64 + fr, col0 = u.pn * HALF + wc * 32 + 8 * fq;
#pragma unroll
        for (int ai = 0; ai < 2; ++ai)
#pragma unroll
            for (int m = 0; m < 4; ++m) { const int row = row0 + ai * HALF + m * 16; const float rs = rstd_row(ssq, row);
                const f32x4 g0 = acc[ai][0][m][0] * rs, g1 = acc[ai][0][m][1] * rs, u0 = acc[ai][1][m][0] * rs, u1 = acc[ai][1][m][1] * rs;
                u32x4 w; w.x = cvt_pk_bf16(silu_mul(g0[0], u0[0]), silu_mul(g0[1], u0[1])); w.y = cvt_pk_bf16(silu_mul(g0[2], u0[2]), silu_mul(g0[3], u0[3]));
                w.z = cvt_pk_bf16(silu_mul(g1[0], u1[0]), silu_mul(g1[1], u1[1])); w.w = cvt_pk_bf16(silu_mul(g1[2], u1[2]), silu_mul(g1[3], u1[3]));
                *(u32x4*)(H + (size_t)row * ldh + col0) = w; }
    }
};
struct EpiQKV {
    static constexpr bool PERM = true, AFTER_DRAIN = false;
    bf16_t* Q; size_t qkv_stride; const float* ssq; float qscale;
    __device__ __forceinline__ void operator()(const f32x4 (&acc)[2][2][4][2], const Unit& u, int wr, int wc, int fr, int fq) const {
        const int row0 = u.pm * BM + wr * 64 + fr; const int t = u.pn >> 1; bf16_t* base = Q + (size_t)t * qkv_stride; const float sc = t == 0 ? qscale : 1.0f;
        const int col0 = (u.pn & 1) * BM + wc * 32 + 8 * fq;
#pragma unroll
        for (int ai = 0; ai < 2; ++ai)
#pragma unroll
            for (int m = 0; m < 4; ++m) { const int row = row0 + ai * HALF + m * 16; const float rs = rstd_row(ssq, row) * sc;
#pragma unroll
                for (int bj = 0; bj < 2; ++bj) { const f32x4 v0 = acc[ai][bj][m][0] * rs, v1 = acc[ai][bj][m][1] * rs;
                    u32x4 w; w.x = cvt_pk_bf16(v0[0], v0[1]); w.y = cvt_pk_bf16(v0[2], v0[3]); w.z = cvt_pk_bf16(v1[0], v1[1]); w.w = cvt_pk_bf16(v1[2], v1[3]);
                    *(u32x4*)(base + (size_t)row * 512 + col0 + bj * HALF) = w; } }
    }
};
struct EpiZT {
    static constexpr bool PERM = true, AFTER_DRAIN = false;
    bf16_t* ZT; int ldz; const float* ssq;
    __device__ __forceinline__ void operator()(const f32x4 (&acc)[2][2][4][2], const Unit& u, int wr, int wc, int fr, int fq) const {
        const int row0 = u.pm * BM + wr * 64 + fr, col0 = u.pn * BM + wc * 32 + 8 * fq;
#pragma unroll
        for (int bj = 0; bj < 2; ++bj) { float cs[8];
#pragma unroll
            for (int j = 0; j < 8; ++j) cs[j] = rstd_row(ssq, col0 + bj * HALF + j);
#pragma unroll
            for (int ai = 0; ai < 2; ++ai)
#pragma unroll
                for (int m = 0; m < 4; ++m) { const int row = row0 + ai * HALF + m * 16; const f32x4 v0 = acc[ai][bj][m][0], v1 = acc[ai][bj][m][1];
                    u32x4 w; w.x = cvt_pk_bf16(v0[0] * cs[0], v0[1] * cs[1]); w.y = cvt_pk_bf16(v0[2] * cs[2], v0[3] * cs[3]);
                    w.z = cvt_pk_bf16(v1[0] * cs[4], v1[1] * cs[5]); w.w = cvt_pk_bf16(v1[2] * cs[6], v1[3] * cs[7]);
                    *(u32x4*)(ZT + (size_t)row * ldz + col0 + bj * HALF) = w; }
            asm volatile("" ::: "memory"); }
    }
};
struct EpiResid {
    static constexpr bool PERM = false, AFTER_DRAIN = true;
    const float* Xin; float* Xout; bf16_t* XB; float* ssq; float scale;
    __device__ __forceinline__ void fused(f32x4 (&acc)[2][2][4][2], const Unit& u, int wr, int wc, int fr, int fq, PG8_LAS unsigned char* lds, int wid, int lane) const {
        typedef unsigned u32x2v __attribute__((ext_vector_type(2)));
        PG8_LAS float* P = (PG8_LAS float*)lds;
        const int col0 = u.pn * BM + wc * 32 + 4 * fq;
#pragma unroll
        for (int ai = 0; ai < 2; ++ai)
#pragma unroll
            for (int m = 0; m < 4; ++m) { const int r = ai * HALF + wr * 64 + m * 16 + fr; const size_t off = (size_t)(u.pm * BM + r) * 1024 + col0; float ss = 0.f;
#pragma unroll
                for (int bj = 0; bj < 2; ++bj)
#pragma unroll
                    for (int n = 0; n < 2; ++n) { const size_t o = off + bj * HALF + n * 16; const f32x4 v = *(const f32x4*)(Xin + o) + acc[ai][bj][m][n] * scale;
                        *(f32x4*)(Xout + o) = v; ss += (v[0] * v[0] + v[1] * v[1]) + (v[2] * v[2] + v[3] * v[3]);
                        if (XB) { u32x2v w; w.x = cvt_pk_bf16(v[0], v[1]); w.y = cvt_pk_bf16(v[2], v[3]); *(u32x2v*)(XB + o) = w; } }
                ss += __shfl_xor(ss, 16); ss += __shfl_xor(ss, 32);
                if (fq == 0) P[r * 4 + wc] = ss;
                if (m & 1) asm volatile("" ::: "memory"); }
        asm volatile("s_waitcnt lgkmcnt(0)" ::: "memory"); __builtin_amdgcn_s_barrier(); asm volatile("" ::: "memory");
        if (ssq) { const int row = wid * 64 + lane; if (row < 256) { const f32x4 p = *(const PG8_LAS f32x4*)(P + row * 4); ssq[(size_t)(u.pm * BM + row) * 4 + u.pn] = (p[0] + p[1]) + (p[2] + p[3]); } }
        asm volatile("s_waitcnt lgkmcnt(0)" ::: "memory"); __builtin_amdgcn_s_barrier(); asm volatile("" ::: "memory");
    }
};

template <class Epi, class Sched, bool ALIGN_EPI = false, bool SP2 = false>
__device__ __forceinline__ void gemm_phase(PG8_LAS unsigned char* lds, const Gemm g, const Sched& S, const Epi& E) {
    int tid_ = threadIdx.x; asm volatile("" : "+v"(tid_));
    const int tid = tid_, wid = __builtin_amdgcn_readfirstlane(tid >> 6), lane = tid & 63, wr = wid >> 2, wc = wid & 3, fr = lane & 15, fq = lane >> 4;
    const int K = g.K, nt = K / BK;
    unsigned voffA[2], voffB[2];
#pragma unroll
    for (int i = 0; i < 2; ++i) { int R, C; stage_rc(tid * 16 + i * 8192, R, C); const int Rb = Epi::PERM ? ((R & ~31) + perm32(R & 31)) : R;
        voffA[i] = (unsigned)(R * K + C) * 2u; voffB[i] = (unsigned)(Rb * K + C) * 2u; }
    const size_t kstep = (size_t)(BK * 2);
    const size_t hstep = (size_t)HALF * K * 2;
    const size_t tstep = 2 * hstep;
    const unsigned ldsw = (unsigned)wid * 1024u;
    const int aoff = lds_byte(wr * 64 + fr, fq * 8), boff = lds_byte(wc * 32 + fr, fq * 8);
#define PG8_SA(b, h) (((b) * 2 + (h)) * HTB)
#define PG8_SB(b, h) ((4 + (b) * 2 + (h)) * HTB)
#define PG8_STAGE(bufoff, gbase, voff) do { _Pragma("unroll") for (int _i = 0; _i < 2; ++_i) \
        __builtin_amdgcn_global_load_lds((const unsigned*)((const char*)(gbase) + (voff)[_i]), (PG8_LAS unsigned*)(lds + (bufoff) + ldsw + _i * 8192), 16, 0, 0); } while (0)
#define PG8_LDA(dst, b, h) do { _Pragma("unroll") for (int m = 0; m < 4; ++m) _Pragma("unroll") for (int k = 0; k < 2; ++k) dst[m][k] = *(const PG8_LAS bf16x8*)(lds + PG8_SA(b, h) + aoff + m * 2048 + k * 1024); } while (0)
#define PG8_LDB(dst, b, h) do { _Pragma("unroll") for (int n = 0; n < 2; ++n) _Pragma("unroll") for (int k = 0; k < 2; ++k) dst[n][k] = *(const PG8_LAS bf16x8*)(lds + PG8_SB(b, h) + boff + n * 2048 + k * 1024); } while (0)
#define PG8_MMA(ai, bj, At, Bt) do { __builtin_amdgcn_s_setprio(1); _Pragma("unroll") for (int m = 0; m < 4; ++m) _Pragma("unroll") for (int n = 0; n < 2; ++n) _Pragma("unroll") for (int k = 0; k < 2; ++k) \
        acc[ai][bj][m][n] = __builtin_amdgcn_mfma_f32_16x16x32_bf16(Bt[n][k], At[m][k], acc[ai][bj][m][n], 0, 0, 0); __builtin_amdgcn_s_setprio(0); } while (0)
#define PG8_WAIT_V(n) asm volatile("s_waitcnt vmcnt(" #n ")" ::: "memory")
#define PG8_WAIT_L(n) asm volatile("s_waitcnt lgkmcnt(" #n ")" ::: "memory")
#define PG8_BAR __builtin_amdgcn_s_barrier()
#define PG8_SCHED __builtin_amdgcn_sched_barrier(0)
    Unit cur, nxt; int ui = 0;
    if (!S.next(0, cur)) return;
    f32x4 acc[2][2][4][2];
#pragma unroll
    for (int a = 0; a < 2; ++a)
#pragma unroll
        for (int b = 0; b < 2; ++b)
#pragma unroll
            for (int m = 0; m < 4; ++m)
#pragma unroll
                for (int n = 0; n < 2; ++n) acc[a][b][m][n] = (f32x4){0.f, 0.f, 0.f, 0.f};
    bf16x8 At[4][2], B0[2][2], B1[2][2];
    const char* cA = (const char*)g.A + (size_t)cur.pm * tstep; const char* cB = (const char*)g.Bt + (size_t)cur.pn * tstep;
    S.a_ready(cur);
    if constexpr (SP2) {
        PG8_STAGE(PG8_SB(0, 0), cB, voffB); PG8_STAGE(PG8_SB(0, 1), cB + hstep, voffB); PG8_STAGE(PG8_SA(0, 0), cA, voffA); PG8_STAGE(PG8_SA(0, 1), cA + hstep, voffA);
        if (wr == 1) PG8_BAR;
        PG8_WAIT_V(2); PG8_BAR;
        PG8_STAGE(PG8_SB(1, 0), cB + kstep, voffB); PG8_STAGE(PG8_SA(1, 0), cA + kstep, voffA); PG8_STAGE(PG8_SB(1, 1), cB + hstep + kstep, voffB);
        PG8_WAIT_V(6); PG8_BAR;
    } else {
        PG8_STAGE(PG8_SB(0, 0), cB, voffB); PG8_STAGE(PG8_SA(0, 0), cA, voffA); PG8_STAGE(PG8_SB(0, 1), cB + hstep, voffB); PG8_STAGE(PG8_SA(0, 1), cA + hstep, voffA);
        if (wr == 1) PG8_BAR;
        PG8_WAIT_V(4); PG8_BAR;
        PG8_STAGE(PG8_SB(1, 0), cB + kstep, voffB); PG8_STAGE(PG8_SA(1, 0), cA + kstep, voffA); PG8_STAGE(PG8_SB(1, 1), cB + hstep + kstep, voffB);
        PG8_WAIT_V(6); PG8_BAR;
    }
    for (;;) {
        const bool has_next = S.next(ui + 1, nxt);
        const char* nA = has_next ? (const char*)g.A + (size_t)nxt.pm * tstep : cA; const char* nB = has_next ? (const char*)g.Bt + (size_t)nxt.pn * tstep : cB;
        for (int t = 0; t < nt; t += 2) {
            const bool last = (t == nt - 2);
            const char* a1 = cA + (size_t)(t + 1) * kstep;
            const char* a2 = last ? nA : cA + (size_t)(t + 2) * kstep; const char* b2 = last ? nB : cB + (size_t)(t + 2) * kstep;
            const char* a3 = a2 + kstep; const char* b3 = b2 + kstep;
            if (last && has_next) S.a_ready(nxt);
            if constexpr (SP2) {
            PG8_LDB(B0, 0, 0); PG8_LDB(B1, 0, 1); PG8_SCHED; PG8_LDA(At, 0, 0); PG8_STAGE(PG8_SA(1, 1), a1 + hstep, voffA);
            PG8_WAIT_V(8); PG8_WAIT_L(0); PG8_BAR; PG8_MMA(0, 0, At, B0); PG8_MMA(0, 1, At, B1); PG8_BAR; PG8_SCHED;
            PG8_LDA(At, 0, 1); PG8_STAGE(PG8_SB(0, 0), b2, voffB); PG8_STAGE(PG8_SB(0, 1), b2 + hstep, voffB); PG8_STAGE(PG8_SA(0, 0), a2, voffA);
            PG8_WAIT_V(8); PG8_WAIT_L(0); PG8_BAR; PG8_MMA(1, 0, At, B0); PG8_MMA(1, 1, At, B1); PG8_BAR; PG8_SCHED;
            PG8_LDB(B0, 1, 0); PG8_LDB(B1, 1, 1); PG8_SCHED; PG8_LDA(At, 1, 0); PG8_STAGE(PG8_SA(0, 1), a2 + hstep, voffA);
            PG8_WAIT_V(8); PG8_WAIT_L(0); PG8_BAR; PG8_MMA(0, 0, At, B0); PG8_MMA(0, 1, At, B1); PG8_BAR; PG8_SCHED;
            PG8_LDA(At, 1, 1); PG8_STAGE(PG8_SB(1, 0), b3, voffB); PG8_STAGE(PG8_SB(1, 1), b3 + hstep, voffB); PG8_STAGE(PG8_SA(1, 0), a3, voffA);
            PG8_WAIT_V(8); PG8_WAIT_L(0); PG8_BAR; PG8_MMA(1, 0, At, B0); PG8_MMA(1, 1, At, B1); PG8_BAR; PG8_SCHED;
            } else {
            PG8_LDB(B0, 0, 0); PG8_SCHED; PG8_LDA(At, 0, 0); PG8_STAGE(PG8_SA(1, 1), a1 + hstep, voffA);
            PG8_WAIT_L(8); PG8_BAR; PG8_WAIT_L(0); PG8_MMA(0, 0, At, B0); PG8_BAR; PG8_SCHED;
            PG8_LDB(B1, 0, 1); PG8_STAGE(PG8_SB(0, 0), b2, voffB);
            PG8_BAR; PG8_WAIT_L(0); PG8_MMA(0, 1, At, B1); PG8_BAR;
            PG8_LDA(At, 0, 1); PG8_STAGE(PG8_SA(0, 0), a2, voffA);
            PG8_BAR; PG8_WAIT_L(0); PG8_MMA(1, 0, At, B0); PG8_BAR; PG8_SCHED;
            PG8_STAGE(PG8_SB(0, 1), b2 + hstep, voffB);
            PG8_WAIT_V(6); PG8_BAR; PG8_MMA(1, 1, At, B1); PG8_BAR;
            PG8_LDB(B0, 1, 0); PG8_SCHED; PG8_LDA(At, 1, 0); PG8_STAGE(PG8_SA(0, 1), a2 + hstep, voffA);
            PG8_WAIT_L(8); PG8_BAR; PG8_WAIT_L(0); PG8_MMA(0, 0, At, B0); PG8_BAR; PG8_SCHED;
            PG8_LDB(B1, 1, 1); PG8_STAGE(PG8_SB(1, 0), b3, voffB);
            PG8_BAR; PG8_WAIT_L(0); PG8_MMA(0, 1, At, B1); PG8_BAR;
            PG8_LDA(At, 1, 1); PG8_STAGE(PG8_SA(1, 0), a3, voffA);
            PG8_BAR; PG8_WAIT_L(0); PG8_MMA(1, 0, At, B0); PG8_BAR; PG8_SCHED;
            PG8_STAGE(PG8_SB(1, 1), b3 + hstep, voffB);
            PG8_WAIT_V(6); PG8_BAR; PG8_MMA(1, 1, At, B1); PG8_BAR;
            }
        }
        if constexpr (ALIGN_EPI) { if (wr == 0) PG8_BAR; }
        if constexpr (!Epi::AFTER_DRAIN) { E(acc, cur, wr, wc, fr, fq); S.done(cur); }
        if (!has_next) break;
#pragma unroll
        for (int a = 0; a < 2; ++a)
#pragma unroll
            for (int b = 0; b < 2; ++b)
#pragma unroll
                for (int m = 0; m < 4; ++m)
#pragma unroll
                    for (int n = 0; n < 2; ++n) acc[a][b][m][n] = (f32x4){0.f, 0.f, 0.f, 0.f};
        cur = nxt; cA = nA; cB = nB; ++ui;
        if constexpr (ALIGN_EPI) { if (wr == 1) PG8_BAR; }
    }
    PG8_WAIT_V(0);
    if constexpr (!ALIGN_EPI) { if (wr == 0) PG8_BAR; }
    PG8_BAR;
    if constexpr (Epi::AFTER_DRAIN) { E.fused(acc, cur, wr, wc, fr, fq, lds, wid, lane); S.done(cur); }
#undef PG8_SA
#undef PG8_SB
#undef PG8_STAGE
#undef PG8_LDA
#undef PG8_LDB
#undef PG8_MMA
#undef PG8_WAIT_V
#undef PG8_WAIT_L
#undef PG8_BAR
#undef PG8_SCHED
}
}
#define GAS __attribute__((address_space(1)))
#define LAS __attribute__((address_space(3)))
typedef unsigned short bf16;
typedef unsigned v4u __attribute__((ext_vector_type(4)));
typedef float f32x4 __attribute__((ext_vector_type(4)));
typedef short bf16x8 __attribute__((ext_vector_type(8)));
typedef GAS unsigned gu32;
typedef GAS unsigned long long gu64;
#define RLX_AGENT __ATOMIC_RELAXED, __HIP_MEMORY_SCOPE_AGENT
#define LDS_WAIT() asm volatile("s_waitcnt lgkmcnt(0)" ::: "memory")
#define VM_WAIT() asm volatile("s_waitcnt vmcnt(0)" ::: "memory")
__device__ __forceinline__ unsigned long long rt() { return __builtin_amdgcn_s_memrealtime(); }
__device__ __forceinline__ unsigned f2bf(float f) { unsigned u = __builtin_bit_cast(unsigned, f); return (u + 0x7fffu + ((u >> 16) & 1u)) >> 16; }
__device__ __forceinline__ unsigned pk2(float lo, float hi) { return f2bf(lo) | (f2bf(hi) << 16); }

#define XB_TMO      128
#define XB_XCNT(j)  (256  + 64 * (j))
#define XB_XSUB(j)  (1280 + 64 * (j))
#define XB_XGEN(j)  (2304 + 64 * (j))
#define XB_TOP      3328
#define XB_TOPGEN   3392
#define XCD_BAR_WORDS 3456
#define XB_SPIN_CAP (1u << 18)

__device__ __forceinline__ unsigned xb_ld(unsigned* p)              { return __hip_atomic_load(p, __ATOMIC_RELAXED, __HIP_MEMORY_SCOPE_AGENT); }
__device__ __forceinline__ unsigned xb_add(unsigned* p, unsigned v) { return __hip_atomic_fetch_add(p, v, __ATOMIC_RELAXED, __HIP_MEMORY_SCOPE_AGENT); }
__device__ __forceinline__ unsigned xb_xcc_id() { return (unsigned)__builtin_amdgcn_s_getreg((3 << 11) | 20) & 0xFu; }
#define XB_SPIN(cond, bar) do { unsigned _sp = 0; while (cond) { __builtin_amdgcn_s_sleep(1); \
    if ((++_sp & 255u) == 0u) { if (xb_ld(&(bar)[XB_TMO])) break; if (_sp > XB_SPIN_CAP) { atomicAdd(&(bar)[XB_TMO], 1u); break; } } } } while (0)

struct XcdBarrier {
    unsigned* bar; unsigned x;
    volatile LAS unsigned* st;
};

__device__ __forceinline__ XcdBarrier xcd_barrier_post(unsigned* bar, volatile LAS unsigned* st) {
    XcdBarrier b; b.bar = bar; b.x = xb_xcc_id(); b.st = st;
    if (threadIdx.x == 0) (void)xb_add(&bar[XB_XCNT(b.x)], 1u);
    return b;
}
__device__ __forceinline__ void xcd_barrier_complete(unsigned* bar, unsigned x, unsigned& nloc, unsigned& nx) {
    const unsigned G = gridDim.x * gridDim.y * gridDim.z;
    unsigned sum, cnt, mine, sp = 0u;
    for (;;) {
        sum = 0u; cnt = 0u; mine = 0u;
#pragma unroll
        for (unsigned j = 0; j < 16; ++j) { const unsigned c = xb_ld(&bar[XB_XCNT(j)]); sum += c; cnt += (c > 0u) ? 1u : 0u; mine = (j == x) ? c : mine; }
        if (sum == G) break;
        __builtin_amdgcn_s_sleep(1);
        if ((++sp & 255u) == 0u) { if (xb_ld(&bar[XB_TMO])) break; if (sp > XB_SPIN_CAP) { atomicAdd(&bar[XB_TMO], 1u); break; } }
    }
    nloc = mine > 0u ? mine : 1u; nx = cnt > 0u ? cnt : 1u;
}

__device__ __forceinline__ void xcd_barrier(const XcdBarrier& b) {
    asm volatile("s_waitcnt vmcnt(0)" ::: "memory");
    __syncthreads();
    if (threadIdx.x == 0) {
        unsigned* bar = b.bar;
        __builtin_amdgcn_s_waitcnt(0);
        unsigned nloc = b.st[0], nx = b.st[1];
        if (nloc == 0u) { xcd_barrier_complete(bar, b.x, nloc, nx); b.st[0] = nloc; b.st[1] = nx; }
        const unsigned old = xb_add(&bar[XB_XSUB(b.x)], 1u);
        const unsigned gen = old / nloc;
        if (old + 1u == (gen + 1u) * nloc) {
            __builtin_amdgcn_fence(__ATOMIC_RELEASE, "agent");
            asm volatile("s_waitcnt vmcnt(0)" ::: "memory");
            const unsigned og = xb_add(&bar[XB_TOP], 1u);
            const unsigned tg = og / nx;
            if (og + 1u == (tg + 1u) * nx) xb_add(&bar[XB_TOPGEN], 1u);
            else XB_SPIN(xb_ld(&bar[XB_TOPGEN]) == tg, bar);
            __builtin_amdgcn_fence(__ATOMIC_ACQUIRE, "agent");
            xb_add(&bar[XB_XGEN(b.x)], 1u);
            asm volatile("s_waitcnt vmcnt(0)" ::: "memory");
        } else {
            XB_SPIN(xb_ld(&bar[XB_XGEN(b.x)]) == gen, bar);
            __builtin_amdgcn_fence(__ATOMIC_ACQUIRE, "agent");
            asm volatile("s_waitcnt vmcnt(0)" ::: "memory");
        }
    }
    __syncthreads();
}

namespace att {
#define ATT_LAS __attribute__((address_space(3)))
typedef short bf16x8 __attribute__((ext_vector_type(8)));
typedef short s16x4 __attribute__((ext_vector_type(4)));
typedef short v4i16_t __attribute__((ext_vector_type(4)));
typedef float f32x16 __attribute__((ext_vector_type(16)));
typedef unsigned u32x4 __attribute__((ext_vector_type(4)));
typedef unsigned short bf16_t;
constexpr int SEQ = 8192, NT = SEQ / 64;
constexpr int KSLOT = 8192, VSLOT = 16384;
constexpr int L_K = 0, L_V = 2 * KSLOT, L_WS = L_V + 2 * VSLOT, L_BT = L_WS + 8 * 64 * 4, L_OST = L_BT + 2048, L_END = L_OST + 8 * 8192;
static_assert(L_END <= 131072, "attention LDS map");
__device__ __forceinline__ int crow(int r, int hi) { return (r & 3) + 8 * (r >> 2) + 4 * hi; }
__device__ __forceinline__ unsigned cvtpk(float lo, float hi) { typedef float f2 __attribute__((ext_vector_type(2))); typedef __bf16 b2 __attribute__((ext_vector_type(2))); f2 v = {lo, hi}; b2 b = __builtin_convertvector(v, b2); return __builtin_bit_cast(unsigned, b); }
__device__ __forceinline__ s16x4 vtr(const ATT_LAS unsigned char* p) { return __builtin_bit_cast(s16x4, __builtin_amdgcn_ds_read_tr16_b64_v4i16((ATT_LAS v4i16_t*)p)); }
__device__ __forceinline__ int t5_bucket(int rel) {
    const int n = rel < 0 ? -rel : rel; int b;
    if (n < 8) b = n; else if (n < 12) b = 8; else if (n < 16) b = 9; else if (n < 23) b = 10; else if (n < 32) b = 11;
    else if (n < 46) b = 12; else if (n < 64) b = 13; else if (n < 91) b = 14; else b = 15;
    return b + (rel > 0 ? 16 : 0);
}
#define ATT_WAIT_BAR() asm volatile("s_waitcnt vmcnt(0) lgkmcnt(0)\n\ts_barrier" ::: "memory")
#define ATT_MFMA(a, b, c) __builtin_amdgcn_mfma_f32_32x32x16_bf16((a), (b), (c), 0, 0, 0)

template <int THRL>
__device__ __forceinline__ void attn_unit(ATT_LAS unsigned char* lds, int b, int h, int qb, const bf16_t* Q, const bf16_t* K, const bf16_t* V, const float* rel_bias,
                                          float lam, const float* subln, float* stash, bf16_t* A2) {
    int tid_ = threadIdx.x; asm volatile("" : "+v"(tid_));
    const int tid = tid_, lane = tid & 63, r32 = lane & 31, hi = lane >> 5; const int wid = __builtin_amdgcn_readfirstlane(tid >> 6);
    const size_t rowbase = (size_t)b * SEQ; const int q0 = qb * 256 + wid * 32;
    ATT_LAS float* wsf = (ATT_LAS float*)(lds + L_WS) + wid * 64;
    ATT_LAS float* btab = (ATT_LAS float*)(lds + L_BT);
    __syncthreads();
    for (int i = tid; i < 257; i += 512) btab[i] = rel_bias[t5_bucket(i - 128) * 4 + h] * 1.4426950408889634f;
    __syncthreads();
    const float bl = btab[0], br = btab[256];
    const unsigned ldsw = (unsigned)wid * 1024u;
    const unsigned vpiece = (unsigned)(((wid >> 2) * 4 + (wid & 3)) * 1024);
    const int vrd = ((lane >> 4) & 1) * 32 + (lane & 3) * 8 + (4 * hi + ((lane & 15) >> 2)) * 64;
    const int krd = hi * 1024 + r32 * 16;
#pragma unroll 1
    for (int c = 0; c < 2; ++c) {
        const bf16_t* Qw = Q + (rowbase + q0) * 512 + h * 128 + c * 64;
        const bf16_t* ksrc = K + rowbase * 512 + h * 128 + c * 64 + (size_t)lane * 512 + wid * 8;
        const bf16_t* vsrc = V + rowbase * 512 + h * 128 + (size_t)(16 * (wid & 3) + (lane >> 2)) * 512 + (wid >> 2) * 32 + (lane & 3) * 8;
#define ATT_DMA(t, s) do { \
        __builtin_amdgcn_global_load_lds((const unsigned*)(ksrc + (size_t)(t) * 64 * 512), (ATT_LAS unsigned*)(lds + L_K + (s) * KSLOT + ldsw), 16, 0, 0); \
        __builtin_amdgcn_global_load_lds((const unsigned*)(vsrc + (size_t)(t) * 64 * 512), (ATT_LAS unsigned*)(lds + L_V + (s) * VSLOT + vpiece), 16, 0, 0); \
        __builtin_amdgcn_global_load_lds((const unsigned*)(vsrc + (size_t)(t) * 64 * 512 + 64), (ATT_LAS unsigned*)(lds + L_V + (s) * VSLOT + vpiece + 8192), 16, 0, 0); } while (0)
        __syncthreads();
        ATT_DMA(0, 0);
        bf16x8 qr[4];
#pragma unroll
        for (int d0 = 0; d0 < 4; ++d0) qr[d0] = *(const bf16x8*)(Qw + (size_t)r32 * 512 + d0 * 16 + hi * 8);
        f32x16 o[4];
#pragma unroll
        for (int d0 = 0; d0 < 4; ++d0)
#pragma unroll
            for (int r = 0; r < 16; ++r) o[d0][r] = 0.f;
        float mhat = 0.f, l_reg = 0.f; bool init_done = false;
#pragma unroll 1
        for (int t = 0; t < NT; ++t) {
            const int s = t & 1;
            ATT_WAIT_BAR();
            if (t + 1 < NT) ATT_DMA(t + 1, s ^ 1);
            const ATT_LAS unsigned char* kp = lds + L_K + s * KSLOT + krd;
            bf16x8 kf[8];
#pragma unroll
            for (int d0 = 0; d0 < 4; ++d0) { kf[2 * d0] = *(const ATT_LAS bf16x8*)(kp + d0 * 2048); kf[2 * d0 + 1] = *(const ATT_LAS bf16x8*)(kp + d0 * 2048 + 512); }
            f32x16 p0, p1;
            const int k0 = t * 64, rlo = k0 - (q0 + 31), rhi = k0 + 63 - q0;
            for (;;) {
                if (rhi <= -91 || rlo >= 91) { const float cv = (rhi <= -91 ? bl : br) - mhat;
#pragma unroll
                    for (int r = 0; r < 16; ++r) { p0[r] = cv; p1[r] = cv; } }
                else { const int dq = k0 + 4 * hi - (q0 + r32);
#pragma unroll
                    for (int r = 0; r < 16; ++r) { int d = dq + (r & 3) + 8 * (r >> 2); int d1 = d + 32;
                        d = d < -128 ? -128 : (d > 128 ? 128 : d); d1 = d1 < -128 ? -128 : (d1 > 128 ? 128 : d1);
                        p0[r] = btab[d + 128] - mhat; p1[r] = btab[d1 + 128] - mhat; } }
#pragma unroll
                for (int d0 = 0; d0 < 4; ++d0) { p0 = ATT_MFMA(kf[2 * d0], qr[d0], p0); p1 = ATT_MFMA(kf[2 * d0 + 1], qr[d0], p1); }
                float rm;
                { float a = fmaxf(fmaxf(p0[0], p0[1]), p1[0]), bq = fmaxf(fmaxf(p0[2], p0[3]), p1[1]); a = fmaxf(fmaxf(a, p1[2]), p1[3]);
#pragma unroll
                  for (int r = 4; r < 16; r += 4) { a = fmaxf(fmaxf(a, p0[r]), p0[r + 1]); bq = fmaxf(fmaxf(bq, p0[r + 2]), p0[r + 3]); a = fmaxf(fmaxf(a, p1[r]), p1[r + 1]); bq = fmaxf(fmaxf(bq, p1[r + 2]), p1[r + 3]); }
                  rm = fmaxf(a, bq); auto rr = __builtin_amdgcn_permlane32_swap(__float_as_uint(rm), __float_as_uint(rm), false, false); rm = fmaxf(__uint_as_float(rr[0]), __uint_as_float(rr[1])); }
                if (!init_done) { mhat = rm; init_done = true; continue; }
                if (!__any(rm > (float)THRL)) break;
                const float dl = fmaxf(rm, 0.f); mhat += dl;
                const float f = __builtin_amdgcn_exp2f(-dl); l_reg *= f; if (hi == 0) wsf[r32] = f;
                asm volatile("s_waitcnt lgkmcnt(0)" ::: "memory");
                float frs[16];
#pragma unroll
                for (int r = 0; r < 16; ++r) frs[r] = wsf[crow(r, hi)];
#pragma unroll
                for (int d0 = 0; d0 < 4; ++d0)
#pragma unroll
                    for (int r = 0; r < 16; ++r) o[d0][r] *= frs[r];
                asm volatile("s_waitcnt lgkmcnt(0)" ::: "memory");
            }
            float sacc = 0.f;
#pragma unroll
            for (int r = 0; r < 16; ++r) { p0[r] = __builtin_amdgcn_exp2f(p0[r]); p1[r] = __builtin_amdgcn_exp2f(p1[r]); sacc += p0[r] + p1[r]; }
            l_reg += sacc;
            u32x4 pw[4];
#pragma unroll
            for (int j = 0; j < 4; ++j) { pw[0][j] = cvtpk(p0[2 * j], p0[2 * j + 1]); pw[1][j] = cvtpk(p0[8 + 2 * j], p0[9 + 2 * j]); pw[2][j] = cvtpk(p1[2 * j], p1[2 * j + 1]); pw[3][j] = cvtpk(p1[8 + 2 * j], p1[9 + 2 * j]); }
            __builtin_amdgcn_sched_barrier(0);
            const ATT_LAS unsigned char* vp = lds + L_V + s * VSLOT + vrd;
#pragma unroll
            for (int d0 = 0; d0 < 4; ++d0) {
                s16x4 vl[4], vh[4];
#pragma unroll
                for (int ks = 0; ks < 4; ++ks) { vl[ks] = vtr(vp + d0 * 4096 + ks * 1024); vh[ks] = vtr(vp + d0 * 4096 + ks * 1024 + 512); }
#pragma unroll
                for (int ks = 0; ks < 4; ++ks) { const bf16x8 vf = (bf16x8){vl[ks][0], vl[ks][1], vl[ks][2], vl[ks][3], vh[ks][0], vh[ks][1], vh[ks][2], vh[ks][3]};
                    o[d0] = ATT_MFMA(__builtin_bit_cast(bf16x8, pw[ks]), vf, o[d0]); }
                __builtin_amdgcn_sched_barrier(0);
            }
        }
        { auto rr = __builtin_amdgcn_permlane32_swap(__float_as_uint(l_reg), __float_as_uint(l_reg), false, false); l_reg = __uint_as_float(rr[0]) + __uint_as_float(rr[1]); }
        if (hi == 0) wsf[32 + r32] = l_reg;
        asm volatile("s_waitcnt lgkmcnt(0)" ::: "memory");
        float rli[16];
#pragma unroll
        for (int r = 0; r < 16; ++r) rli[r] = __builtin_amdgcn_rcpf(wsf[32 + crow(r, hi)]);
        asm volatile("s_waitcnt lgkmcnt(0)" ::: "memory");
        size_t sbase = (rowbase + q0 + 4 * hi) * 512 + h * 128 + r32; asm volatile("" : "+v"(sbase));
        float* st = stash + sbase;
        if (c == 0) {
#pragma unroll
            for (int r = 0; r < 16; ++r)
#pragma unroll
                for (int d0 = 0; d0 < 4; ++d0) st[(size_t)((r & 3) + 8 * (r >> 2)) * 512 + d0 * 32] = o[d0][r] * rli[r];
        } else {
#ifndef NO_EPI1
            float ss[16];
#pragma unroll
            for (int r = 0; r < 16; ++r) { float sq = 0.f;
#pragma unroll
                for (int d0 = 0; d0 < 4; ++d0) { const float dv = st[(size_t)((r & 3) + 8 * (r >> 2)) * 512 + d0 * 32] - lam * (o[d0][r] * rli[r]); o[d0][r] = dv; sq += dv * dv; }
                ss[r] = sq; if ((r & 3) == 3) asm volatile("" ::: "memory"); }
#pragma unroll
            for (int off = 1; off < 32; off <<= 1)
#pragma unroll
                for (int r = 0; r < 16; ++r) ss[r] += __shfl_xor(ss[r], off);
            float g4[4];
#pragma unroll
            for (int d0 = 0; d0 < 4; ++d0) g4[d0] = subln[d0 * 32 + r32] * 0.8f;
            ATT_LAS bf16_t* stg = (ATT_LAS bf16_t*)(lds + L_OST) + wid * 4096;
#pragma unroll
            for (int r = 0; r < 16; ++r) { const float rs = __builtin_amdgcn_rsqf(ss[r] * (1.0f / 128.0f) + 1e-6f);
#pragma unroll
                for (int d0 = 0; d0 < 4; ++d0) { const float v = o[d0][r] * rs * g4[d0]; const unsigned u = __float_as_uint(v); stg[crow(r, hi) * 128 + d0 * 32 + r32] = (bf16_t)((u + 0x7fffu + ((u >> 16) & 1u)) >> 16); } }
            asm volatile("s_waitcnt lgkmcnt(0)" ::: "memory");
            size_t obase = (rowbase + q0 + (lane >> 4)) * 1024 + h * 128 + (lane & 15) * 8; asm volatile("" : "+v"(obase));
            bf16_t* Ow = A2 + obase;
#pragma unroll
            for (int i = 0; i < 8; ++i) { const int row = i * 4 + (lane >> 4), ch = lane & 15; const u32x4 v = *(const ATT_LAS u32x4*)(stg + row * 128 + ch * 8); *(u32x4*)(Ow + (size_t)(i * 4) * 1024) = v; }
            asm volatile("s_waitcnt lgkmcnt(0)" ::: "memory");
#endif
        }
#undef ATT_DMA
    }
}
}

namespace hyc {
#define HYC_LAS __attribute__((address_space(3)))
#define HYC_GAS __attribute__((address_space(1)))
typedef short bf16x8 __attribute__((ext_vector_type(8)));
typedef bf16x8 ubf16x8 __attribute__((aligned(2)));
typedef float f32x16 __attribute__((ext_vector_type(16)));
typedef unsigned u32x4 __attribute__((ext_vector_type(4)));
typedef u32x4 u32x4a4 __attribute__((aligned(4)));
typedef unsigned short bf16_t;
constexpr int SEQ = 8192, M = 16384;
constexpr int UBLK = 144, UBOFF = 160 * UBLK;
constexpr int L_U = 0, L_T0 = 49152, L_T1 = 81920, L_F0 = 49152, L_F1 = L_F0 + 32768 + 68, L_END = L_F1 + 32768;
static_assert(2 * UBOFF <= L_T0 && (UBOFF % 256) == 0 && L_END <= 131072, "conv LDS map");
__device__ __forceinline__ float bf2f(bf16_t b) { return __builtin_bit_cast(float, (unsigned)b << 16); }
__device__ __forceinline__ unsigned f2bf(float f) { unsigned u = __builtin_bit_cast(unsigned, f); return (u + 0x7fffu + ((u >> 16) & 1u)) >> 16; }
__device__ __forceinline__ int crow(int r, int hi) { return (r & 3) + 8 * (r >> 2) + 4 * hi; }

__device__ __forceinline__ void sconv8(const HYC_LAS bf16_t* T, int m0, float w0, float w1, float w2, float bb, float (&u)[8]) {
    const u32x4 v = *(const HYC_LAS u32x4*)(T + m0);
    float z[10]; const int t = m0 & (SEQ - 1);
    z[0] = t > 0 ? bf2f(T[m0 - 1]) : 0.f; z[9] = t + 8 < SEQ ? bf2f(T[m0 + 8]) : 0.f;
#pragma unroll
    for (int j = 0; j < 4; ++j) { z[1 + 2 * j] = __builtin_bit_cast(float, v[j] << 16); z[2 + 2 * j] = __builtin_bit_cast(float, v[j] & 0xffff0000u); }
#pragma unroll
    for (int j = 0; j < 8; ++j) u[j] = bb + w0 * z[j] + w1 * z[j + 1] + w2 * z[j + 2];
}

__device__ __forceinline__ void conv_channel(HYC_LAS unsigned char* lds, int c, const bf16_t* ZT, const bf16_t* GR, const float* cw, const float* cb, float hb, bf16_t* YT) {
    int tid_ = threadIdx.x; asm volatile("" : "+v"(tid_));
    const int tid = tid_, lane = tid & 63, r32 = lane & 31, hi = lane >> 5; const int wid = __builtin_amdgcn_readfirstlane(tid >> 6);
    HYC_LAS bf16_t* T0 = (HYC_LAS bf16_t*)(lds + L_T0); HYC_LAS bf16_t* T1 = (HYC_LAS bf16_t*)(lds + L_T1);
    const bf16_t* z0row = ZT + (size_t)c * M;
    __syncthreads();
    for (int i = tid; i < M / 8; i += 512) ((HYC_LAS u32x4*)T0)[i] = ((const HYC_GAS u32x4*)z0row)[i];
    __syncthreads();
    { const float w0 = cw[c], w1 = cw[1536 + c], w2 = cw[3072 + c], bb = cb[c];
      for (int i = tid; i < M / 8; i += 512) { float u[8]; sconv8(T0, i * 8, w0, w1, w2, bb, u);
          u32x4 o; o.x = f2bf(u[0]) | (f2bf(u[1]) << 16); o.y = f2bf(u[2]) | (f2bf(u[3]) << 16); o.z = f2bf(u[4]) | (f2bf(u[5]) << 16); o.w = f2bf(u[6]) | (f2bf(u[7]) << 16);
          ((HYC_GAS u32x4*)(YT + (size_t)c * M))[i] = o; } }
    __syncthreads();
    for (int i = tid; i < M / 8; i += 512) { ((HYC_LAS u32x4*)T0)[i] = ((const HYC_GAS u32x4*)(ZT + (size_t)(512 + c) * M))[i]; ((HYC_LAS u32x4*)T1)[i] = ((const HYC_GAS u32x4*)(ZT + (size_t)(1024 + c) * M))[i]; }
    for (int i = tid; i < 2 * 2 * 16 * (UBLK / 16); i += 512) { const int b = i / (2 * 16 * 9), rem = i % (2 * 16 * 9), side = rem / (16 * 9), q = rem % (16 * 9);
        *(HYC_LAS u32x4*)(lds + L_U + b * UBOFF + side * (144 * UBLK) + q * 16) = (u32x4){0u, 0u, 0u, 0u}; }
    __syncthreads();
    { const float a0 = cw[512 + c], a1 = cw[1536 + 512 + c], a2 = cw[3072 + 512 + c], ab = cb[512 + c];
      const float v0 = cw[1024 + c], v1 = cw[1536 + 1024 + c], v2 = cw[3072 + 1024 + c], vb = cb[1024 + c];
      for (int i = tid; i < M / 8; i += 512) { float ux[8], uv[8]; sconv8(T0, i * 8, a0, a1, a2, ab, ux); sconv8(T1, i * 8, v0, v1, v2, vb, uv);
          u32x4 o; o.x = f2bf(ux[0] * uv[0]) | (f2bf(ux[1] * uv[1]) << 16); o.y = f2bf(ux[2] * uv[2]) | (f2bf(ux[3] * uv[3]) << 16);
          o.z = f2bf(ux[4] * uv[4]) | (f2bf(ux[5] * uv[5]) << 16); o.w = f2bf(ux[6] * uv[6]) | (f2bf(ux[7] * uv[7]) << 16);
          const int m0 = i * 8, b = m0 >> 13, t = m0 & (SEQ - 1);
          *(HYC_LAS u32x4*)(lds + L_U + b * UBOFF + ((t >> 6) + 16) * UBLK + (t & 63) * 2) = o; } }
    __syncthreads();
    { const bf16_t* grow = GR + (size_t)c * 16384;
      for (int i = tid; i < 16384 / 8; i += 512) { const u32x4 v = ((const HYC_GAS u32x4*)grow)[i]; const unsigned nx = ((const HYC_GAS unsigned*)grow)[4 * i + 4 < 8192 ? 4 * i + 4 : 8191];
          ((HYC_LAS u32x4*)(lds + L_F0))[i] = v;
          HYC_LAS unsigned* f1 = (HYC_LAS unsigned*)(lds + L_F1) + 4 * i;
          f1[0] = (v.x >> 16) | (v.y << 16); f1[1] = (v.y >> 16) | (v.z << 16); f1[2] = (v.z >> 16) | (v.w << 16); f1[3] = (v.w >> 16) | (nx << 16); } }
    __syncthreads();
    const int i0 = 16 * wid, dlo = i0 - 127;
    const int il = r32 & 15, bb_ = r32 >> 4;
    int aoff = L_U + bb_ * UBOFF + (i0 + il - dlo + 16) * UBLK + hi * 16;
    int goff = ((r32 & 1) ? (L_F1 - 2) : L_F0) + 2 * (8192 - (64 * dlo + r32 - 8 * hi));
#define HYC_LDF(off) __builtin_bit_cast(bf16x8, *(const HYC_LAS u32x4a4*)(lds + (off)))
    bf16x8 f0 = HYC_LDF(goff - 64), f1 = HYC_LDF(goff - 32), f2 = HYC_LDF(goff), f3 = HYC_LDF(goff + 32), f4 = HYC_LDF(goff + 64), f5 = HYC_LDF(goff + 96);
    f32x16 acc0, acc1;
#pragma unroll
    for (int r = 0; r < 16; ++r) { acc0[r] = 0.f; acc1[r] = 0.f; }
#pragma unroll 1
    for (int e = 0; e < 143; ++e) {
        const int gn = goff - (e < 142 ? 128 : 0);
        const bf16x8 n0 = HYC_LDF(gn - 64), n1 = HYC_LDF(gn - 32), n2 = HYC_LDF(gn), n3 = HYC_LDF(gn + 32);
        const bf16x8 a0 = *(const HYC_LAS bf16x8*)(lds + aoff), a1 = *(const HYC_LAS bf16x8*)(lds + aoff + 32), a2 = *(const HYC_LAS bf16x8*)(lds + aoff + 64), a3 = *(const HYC_LAS bf16x8*)(lds + aoff + 96);
        acc0 = __builtin_amdgcn_mfma_f32_32x32x16_bf16(a0, f2, acc0, 0, 0, 0); acc1 = __builtin_amdgcn_mfma_f32_32x32x16_bf16(a0, f0, acc1, 0, 0, 0);
        acc0 = __builtin_amdgcn_mfma_f32_32x32x16_bf16(a1, f3, acc0, 0, 0, 0); acc1 = __builtin_amdgcn_mfma_f32_32x32x16_bf16(a1, f1, acc1, 0, 0, 0);
        acc0 = __builtin_amdgcn_mfma_f32_32x32x16_bf16(a2, f4, acc0, 0, 0, 0); acc1 = __builtin_amdgcn_mfma_f32_32x32x16_bf16(a2, f2, acc1, 0, 0, 0);
        acc0 = __builtin_amdgcn_mfma_f32_32x32x16_bf16(a3, f5, acc0, 0, 0, 0); acc1 = __builtin_amdgcn_mfma_f32_32x32x16_bf16(a3, f3, acc1, 0, 0, 0);
        f4 = f0; f5 = f1; f0 = n0; f1 = n1; f2 = n2; f3 = n3; goff = gn; aoff -= UBLK;
    }
#undef HYC_LDF
    bf16_t* yrow = YT + (size_t)c * M;
#pragma unroll
    for (int nt = 0; nt < 2; ++nt)
#pragma unroll
        for (int r = 0; r < 16; ++r) { const int rho = crow(r, hi), i = i0 + (rho & 15), b = rho >> 4, t = 64 * i + 32 * nt + r32, m = b * SEQ + t;
            const float vx = bf2f(*(const HYC_LAS bf16_t*)(lds + L_U + b * UBOFF + (i + 16) * UBLK + (32 * nt + r32) * 2));
            const float x0 = bf2f(yrow[m]);
            const float a = nt == 0 ? acc0[r] : acc1[r];
            yrow[m] = (bf16_t)f2bf((a + vx * hb) * x0); }
}
}

constexpr int NWAVES = 8;
constexpr int BATCH = 2, SEQ = 8192, D = 1024, M = BATCH * SEQ, FF = 2816, DIN = 3072, NH = 4;
constexpr float EPS = 1e-6f;
constexpr float LOG2E = 1.4426950408889634f;
constexpr float C2 = 0.125f * LOG2E;

constexpr size_t MiB = 1u << 20;
constexpr size_t WS_CTL = 0, CTL_ZERO_BYTES = 64 * 1024;
constexpr size_t WS_WGU1 = 1 * MiB;
constexpr size_t WS_WD1 = 12 * MiB;
constexpr size_t WS_WIN = 18 * MiB;
constexpr size_t WS_WOUT = 24 * MiB;
constexpr size_t WS_WGU2 = 26 * MiB;
constexpr size_t WS_WD2 = 37 * MiB;
constexpr size_t WS_SSQ = 43 * MiB;
constexpr size_t WS_G = 46 * MiB;
constexpr size_t WS_XB = 62 * MiB;
constexpr size_t WS_X1 = 94 * MiB;
constexpr size_t WS_H = 158 * MiB;
constexpr size_t WS_Q = WS_H, WS_K = WS_H + 16 * MiB, WS_V = WS_H + 32 * MiB;
constexpr size_t WS_A2 = WS_H + 48 * MiB;
constexpr size_t WS_END = 246 * MiB;
constexpr size_t DO_ZT = 0, DO_YT = 48 * MiB;
constexpr int CW_TMO = 0, CW_BAR = 4096;

constexpr int RING_OFF = 0, RING_BYTES = 131072;
constexpr int LDSCTL_OFF = RING_BYTES, MISC_OFF = LDSCTL_OFF + 320;
constexpr int LDS_BYTES = 147456;

struct Frame {
    LAS unsigned char* lds;
    volatile LAS unsigned* MISC;
    gu32* ctl;
    int tid, lane, wave;
    int vcu, G;
};

__device__ __forceinline__ float bf2f(bf16 b) { return __builtin_bit_cast(float, (unsigned)b << 16); }
__device__ __forceinline__ float wave_sum(float v) {
#pragma unroll
    for (int o = 1; o < 64; o <<= 1) v += __shfl_xor(v, o);
    return v;
}

__device__ __forceinline__ void p0_transpose_item(const float* W, const float* gain, int K, int N, bf16* WT, int item, int mode, int up, LAS float* scr, int lane) {
    const int nblk = N / 32, kb = item / nblk, nb = item % nblk, k0 = 64 * kb, n0 = 32 * nb;
    const int dst_row0 = mode ? (256 * (n0 / 128) + (n0 % 128) + 128 * up) : n0;
    const int q = lane >> 3, c4 = (lane & 7) * 4;
    f32x4 v[8]; float g[8];
#pragma unroll
    for (int j = 0; j < 8; ++j) { v[j] = *(const GAS f32x4*)(W + (size_t)(k0 + 8 * j + q) * N + n0 + c4); g[j] = gain ? gain[k0 + 8 * j + q] : 1.0f; }
#pragma unroll
    for (int j = 0; j < 8; ++j) { LAS float* d = scr + (8 * j + q) * 33 + c4; d[0] = v[j].x * g[j]; d[1] = v[j].y * g[j]; d[2] = v[j].z * g[j]; d[3] = v[j].w * g[j]; }
    LDS_WAIT(); asm volatile("" ::: "memory");
    const int c = lane & 7;
#pragma unroll
    for (int j = 0; j < 4; ++j) { const int n = (lane >> 3) + 8 * j; const LAS float* s = scr + (8 * c) * 33 + n;
        v4u o; o.x = pk2(s[0 * 33], s[1 * 33]); o.y = pk2(s[2 * 33], s[3 * 33]); o.z = pk2(s[4 * 33], s[5 * 33]); o.w = pk2(s[6 * 33], s[7 * 33]);
        *(GAS v4u*)(WT + (size_t)(dst_row0 + n) * K + k0 + 8 * c) = o; }
    LDS_WAIT(); asm volatile("" ::: "memory");
}
__device__ __forceinline__ void row_to_bf16_ssq2(const float* x0, const float* x1, bf16* o0, bf16* o1, float* s0, float* s1, int lane) {
    f32x4 a[4], b[4];
#pragma unroll
    for (int p = 0; p < 4; ++p) { a[p] = *(const GAS f32x4*)(x0 + p * 256 + lane * 4); b[p] = *(const GAS f32x4*)(x1 + p * 256 + lane * 4); }
#pragma unroll
    for (int p = 0; p < 4; ++p) { const float sa = wave_sum((a[p].x * a[p].x + a[p].y * a[p].y) + (a[p].z * a[p].z + a[p].w * a[p].w)), sb = wave_sum((b[p].x * b[p].x + b[p].y * b[p].y) + (b[p].z * b[p].z + b[p].w * b[p].w));
        if (lane == 0) { s0[p] = sa; s1[p] = sb; }
        *(GAS unsigned long long*)(o0 + p * 256 + lane * 4) = (unsigned long long)pk2(a[p].x, a[p].y) | ((unsigned long long)pk2(a[p].z, a[p].w) << 32);
        *(GAS unsigned long long*)(o1 + p * 256 + lane * 4) = (unsigned long long)pk2(b[p].x, b[p].y) | ((unsigned long long)pk2(b[p].z, b[p].w) << 32); }
}
__device__ __forceinline__ void p0_filters_unit(Frame& F, const float* const* in, bf16* G, int u) {
    LAS float* a3s = (LAS float*)(F.lds + RING_OFF);
    const float *w1 = in[15], *b1 = in[16], *w2 = in[17], *b2 = in[18], *w3 = in[19], *b3 = in[20], *w4 = in[21], *freq = in[22];
    const int lane = F.lane; const float fr = freq[lane];
    for (int q = 0; q < 4; ++q) { const int pl = F.wave * 4 + q, i = 32 * u + pl;
        float z = 0.f;
        { const float w = (6.283185307179586f * (float)i) / (float)SEQ; const int j = (lane - 1) & 15; const float f = 1e-4f + (float)j * ((15.0f - 1e-4f) / 15.0f); const float fw = f * w;
          if (lane == 0) z = (float)i / (float)(SEQ - 1); else if (lane <= 16) z = cosf(fw); else if (lane <= 32) z = -sinf(fw); }
        float s = b1[lane];
        for (int e = 0; e < 33; ++e) s += __shfl(z, e) * w1[e * 64 + lane];
        float a = sinf(fr * s);
        s = b2[lane];
        for (int e = 0; e < 64; ++e) s += __shfl(a, e) * w2[e * 64 + lane];
        a = sinf(fr * s);
        s = b3[lane];
        for (int e = 0; e < 64; ++e) s += __shfl(a, e) * w3[e * 64 + lane];
        a3s[pl * 64 + lane] = sinf(fr * s); }
    __syncthreads();
    { const int c = F.tid; float acc0[32], acc1[32];
#pragma unroll
      for (int p = 0; p < 32; ++p) { acc0[p] = 0.f; acc1[p] = 0.f; }
      for (int k = 0; k < 64; ++k) { const float wa = w4[k * 1024 + c], wb = w4[k * 1024 + 512 + c];
#pragma unroll
          for (int p = 0; p < 32; ++p) { const float a = a3s[p * 64 + k]; acc0[p] += a * wa; acc1[p] += a * wb; } }
      const float mind = logf(1e-2f) / 1.5f, maxd = logf(1e-2f) / 0.3f; const float ad = fabsf(mind + (float)c * ((maxd - mind) / 511.0f));
      bf16* gc = G + (size_t)c * 16384 + 8192; const int i0 = 32 * u;
#pragma unroll
      for (int p8 = 0; p8 < 4; ++p8) { unsigned w[4];
#pragma unroll
          for (int h = 0; h < 4; ++h) { const int p = p8 * 8 + 2 * h; const float d0 = expf(-((float)(i0 + p) / (float)(SEQ - 1)) * ad), d1 = expf(-((float)(i0 + p + 1) / (float)(SEQ - 1)) * ad);
              const float e0 = (i0 + p == 0) ? acc0[p] : acc1[p];
              w[h] = pk2(e0 * d0, acc1[p + 1] * d1); }
          *(GAS v4u*)(gc + i0 + p8 * 8) = (v4u){w[0], w[1], w[2], w[3]}; }
#pragma unroll
      for (int p = 0; p < 32; ++p) { const int i = i0 + p; const float dd = expf(-((float)i / (float)(SEQ - 1)) * ad);
          if (i >= 1) gc[-i] = (bf16)f2bf(acc0[p] * dd); else gc[-8192] = 0; }
    }
    __syncthreads();
}

constexpr int I_GU = (D / 64) * (FF / 32), I_DN = (FF / 64) * (D / 32), I_IN = (D / 64) * (DIN / 32), I_OUT = (D / 64) * (D / 32);
constexpr int NITEMS = 4 * I_GU + 2 * I_DN + I_IN + I_OUT;
__device__ __forceinline__ void p0_transpose_range(Frame& F, const float* const* in, unsigned char* ws, int first, int last, int gw, int NGW) {
    LAS float* scr = (LAS float*)(F.lds + RING_OFF + F.wave * 16384);
    bf16 *Wgu1 = (bf16*)(ws + WS_WGU1), *Wd1 = (bf16*)(ws + WS_WD1), *Win = (bf16*)(ws + WS_WIN), *Wout = (bf16*)(ws + WS_WOUT), *Wgu2 = (bf16*)(ws + WS_WGU2), *Wd2 = (bf16*)(ws + WS_WD2);
    for (int it = first + gw; it < last; it += NGW) {
        int r = it;
        if (r < I_GU) { p0_transpose_item(in[3], in[2], D, FF, Wgu1, r, 1, 0, scr, F.lane); continue; } r -= I_GU;
        if (r < I_GU) { p0_transpose_item(in[4], in[2], D, FF, Wgu1, r, 1, 1, scr, F.lane); continue; } r -= I_GU;
        if (r < I_DN) { p0_transpose_item(in[5], nullptr, FF, D, Wd1, r, 0, 0, scr, F.lane); continue; } r -= I_DN;
        if (r < I_IN) { p0_transpose_item(in[7], in[6], D, DIN, Win, r, 0, 0, scr, F.lane); continue; } r -= I_IN;
        if (r < I_OUT) { p0_transpose_item(in[25], nullptr, D, D, Wout, r, 0, 0, scr, F.lane); continue; } r -= I_OUT;
        if (r < I_GU) { p0_transpose_item(in[27], in[26], D, FF, Wgu2, r, 1, 0, scr, F.lane); continue; } r -= I_GU;
        if (r < I_GU) { p0_transpose_item(in[28], in[26], D, FF, Wgu2, r, 1, 1, scr, F.lane); continue; } r -= I_GU;
        p0_transpose_item(in[29], nullptr, FF, D, Wd2, r, 0, 0, scr, F.lane);
    }
}
__device__ __forceinline__ void p0_early(Frame& F, const float* const* in, unsigned char* ws) {
    const int gw = F.vcu * NWAVES + F.wave, NGW = F.G * NWAVES;
    p0_transpose_range(F, in, ws, 0, 2 * I_GU, gw, NGW);
    bf16* XB = (bf16*)(ws + WS_XB); float* ssq = (float*)(ws + WS_SSQ);
    for (int m = 2 * gw; m < M; m += 2 * NGW) row_to_bf16_ssq2(in[0] + (size_t)m * D, in[0] + (size_t)(m + 1) * D, XB + (size_t)m * D, XB + (size_t)(m + 1) * D, ssq + (size_t)m * 4, ssq + (size_t)(m + 1) * 4, F.lane);
}
__device__ __forceinline__ void p0_late(Frame& F, const float* const* in, unsigned char* ws, int rank, int nranks) {
    bf16* G = (bf16*)(ws + WS_G);
    __syncthreads();
    for (int u = rank; u < SEQ / 32; u += nranks) p0_filters_unit(F, in, G, u);
    __syncthreads();
    p0_transpose_range(F, in, ws, 2 * I_GU, NITEMS, rank * NWAVES + F.wave, nranks * NWAVES);
    __syncthreads();
}

__device__ __forceinline__ int t5_bucket(int rel) {
    const int n = rel < 0 ? -rel : rel; int b;
    if (n < 8) b = n; else if (n < 12) b = 8; else if (n < 16) b = 9; else if (n < 23) b = 10; else if (n < 32) b = 11;
    else if (n < 46) b = 12; else if (n < 64) b = 13; else if (n < 91) b = 14; else b = 15;
    return b + (rel > 0 ? 16 : 0);
}

__device__ __forceinline__ void attn_simple_pair(Frame& F, int vb, const bf16* Q, const bf16* K, const bf16* V, const float* const* in, bf16* A2) {
    const int half = F.tid >> 8, tid = F.tid & 255, part = tid & 7, ql = tid >> 3;
    LAS float* Ks = (LAS float*)(F.lds + RING_OFF + half * 20480);
    LAS float* Vs = Ks + 16 * 128;
    LAS float* btab = Vs + 16 * 128;
    LAS float* lam_s = btab + 260;
    const int qblk = vb & 255, h = (vb >> 8) & 3, b = vb >> 10;
    const int qpos = qblk * 32 + ql; const size_t mrow = (size_t)b * SEQ + qpos;
    const float* rel_bias = in[1];
    __syncthreads();
    for (int i = tid; i < 257; i += 256) btab[i] = rel_bias[t5_bucket(i - 128) * NH + h] * LOG2E;
    if (tid == 0) { float s1 = 0.f, s2 = 0.f; for (int i = 0; i < 64; ++i) { s1 += in[8][i] * in[9][i]; s2 += in[10][i] * in[11][i]; } lam_s[0] = expf(s1) - expf(s2) + 0.2f; }
    float q1[8], q2[8];
#pragma unroll
    for (int d = 0; d < 8; ++d) { q1[d] = bf2f(Q[mrow * 512 + h * 128 + part * 8 + d]); q2[d] = bf2f(Q[mrow * 512 + h * 128 + 64 + part * 8 + d]); }
    float o1[16], o2[16];
#pragma unroll
    for (int e = 0; e < 16; ++e) { o1[e] = 0.f; o2[e] = 0.f; }
    float m1 = -1e30f, m2 = -1e30f, l1 = 0.f, l2 = 0.f;
    for (int k0 = 0; k0 < SEQ; k0 += 8) {
        __syncthreads();
        for (int i = tid; i < 8 * 128; i += 256) { const int kk = i >> 7, c = i & 127; const size_t kr = (size_t)b * SEQ + k0 + kk;
            Ks[kk * 128 + c] = bf2f(K[kr * 512 + h * 128 + c]); Vs[kk * 128 + c] = bf2f(V[kr * 512 + h * 128 + c]); }
        __syncthreads();
        float s1[8], s2[8]; float t1 = -1e30f, t2 = -1e30f;
#pragma unroll
        for (int j = 0; j < 8; ++j) { float a = 0.f, c = 0.f;
#pragma unroll
            for (int d = 0; d < 8; ++d) { a += q1[d] * Ks[j * 128 + part * 8 + d]; c += q2[d] * Ks[j * 128 + 64 + part * 8 + d]; }
            a += __shfl_xor(a, 1); a += __shfl_xor(a, 2); a += __shfl_xor(a, 4); c += __shfl_xor(c, 1); c += __shfl_xor(c, 2); c += __shfl_xor(c, 4);
            int rel = k0 + j - qpos; rel = rel < -128 ? -128 : (rel > 128 ? 128 : rel); const float bb = btab[rel + 128];
            a += bb; c += bb; s1[j] = a; s2[j] = c; t1 = fmaxf(t1, a); t2 = fmaxf(t2, c); }
        const float n1 = fmaxf(m1, t1), n2 = fmaxf(m2, t2); const float a1 = exp2f(m1 - n1), a2 = exp2f(m2 - n2);
        m1 = n1; m2 = n2; l1 *= a1; l2 *= a2;
#pragma unroll
        for (int e = 0; e < 16; ++e) { o1[e] *= a1; o2[e] *= a2; }
#pragma unroll
        for (int j = 0; j < 8; ++j) { const float p1 = exp2f(s1[j] - m1), p2 = exp2f(s2[j] - m2); l1 += p1; l2 += p2;
#pragma unroll
            for (int e = 0; e < 16; ++e) { const float v = Vs[j * 128 + part * 16 + e]; o1[e] += p1 * v; o2[e] += p2 * v; } }
    }
    const float lam = lam_s[0]; const float i1 = 1.f / l1, i2 = lam / l2; float ss = 0.f;
#pragma unroll
    for (int e = 0; e < 16; ++e) { o1[e] = o1[e] * i1 - o2[e] * i2; ss += o1[e] * o1[e]; }
    ss += __shfl_xor(ss, 1); ss += __shfl_xor(ss, 2); ss += __shfl_xor(ss, 4);
    const float rs = rsqrtf(ss * (1.f / 128.f) + EPS) * 0.8f; const float* subln = in[12];
#pragma unroll
    for (int e = 0; e < 16; ++e) A2[mrow * D + h * 128 + part * 16 + e] = (bf16)f2bf(o1[e] * rs * subln[part * 16 + e]);
}

__device__ __forceinline__ void hyena_simple_channel(Frame& F, int c, const bf16* ZT, const bf16* G, const float* const* in, bf16* YT) {
    LAS bf16* X0 = (LAS bf16*)(F.lds + RING_OFF);
    LAS bf16* U = (LAS bf16*)(F.lds + RING_OFF + 32768);
    LAS bf16* T0 = (LAS bf16*)(F.lds + RING_OFF + 65536);
    LAS bf16* T1 = (LAS bf16*)(F.lds + RING_OFF + 98304);
    const float* cw = in[13]; const float* cb = in[14];
    __syncthreads();
    for (int i = F.tid; i < M / 8; i += 512) ((LAS v4u*)T0)[i] = ((const GAS v4u*)(ZT + (size_t)c * M))[i];
    __syncthreads();
    { const float w0 = cw[c], w1 = cw[1536 + c], w2 = cw[3072 + c], bb = cb[c];
      for (int m = F.tid; m < M; m += 512) { const int t = m & (SEQ - 1);
          const float zm = t > 0 ? bf2f(T0[m - 1]) : 0.f, z0 = bf2f(T0[m]), zp = t < SEQ - 1 ? bf2f(T0[m + 1]) : 0.f;
          X0[m] = (bf16)f2bf(bb + w0 * zm + w1 * z0 + w2 * zp); } }
    __syncthreads();
    for (int i = F.tid; i < M / 8; i += 512) { ((LAS v4u*)T0)[i] = ((const GAS v4u*)(ZT + (size_t)(512 + c) * M))[i]; ((LAS v4u*)T1)[i] = ((const GAS v4u*)(ZT + (size_t)(1024 + c) * M))[i]; }
    __syncthreads();
    { const float a0 = cw[512 + c], a1 = cw[1536 + 512 + c], a2 = cw[3072 + 512 + c], ab = cb[512 + c];
      const float v0 = cw[1024 + c], v1 = cw[1536 + 1024 + c], v2 = cw[3072 + 1024 + c], vb = cb[1024 + c];
      for (int m = F.tid; m < M; m += 512) { const int t = m & (SEQ - 1);
          const float xm = t > 0 ? bf2f(T0[m - 1]) : 0.f, x0 = bf2f(T0[m]), xp = t < SEQ - 1 ? bf2f(T0[m + 1]) : 0.f;
          const float ym = t > 0 ? bf2f(T1[m - 1]) : 0.f, y0 = bf2f(T1[m]), yp = t < SEQ - 1 ? bf2f(T1[m + 1]) : 0.f;
          U[m] = (bf16)f2bf((ab + a0 * xm + a1 * x0 + a2 * xp) * (vb + v0 * ym + v1 * y0 + v2 * yp)); } }
    __syncthreads();
    const int half = F.tid >> 8, tid = F.tid & 255;
    LAS float* gs = (LAS float*)(F.lds + RING_OFF + 65536 + half * 8192);
    const bf16* g = G + (size_t)c * 16384 + 8192; const float hb = in[23][c];
    for (int vbk = half; vbk < 16; vbk += 2) { const int b = vbk >> 3, t0 = (vbk & 7) * 1024;
        float acc[4] = {0.f, 0.f, 0.f, 0.f};
        for (int s0 = 0; s0 < SEQ; s0 += 256) {
            __syncthreads();
            for (int i = tid; i < 1279; i += 256) { const int d = t0 - s0 - 255 + i; gs[i] = (d > -8192 && d < 8192) ? bf2f(g[-d]) : 0.f; }
            __syncthreads();
#pragma unroll 8
            for (int sl = 0; sl < 256; ++sl) { const float uu = bf2f(U[b * SEQ + s0 + sl]);
#pragma unroll
                for (int j = 0; j < 4; ++j) acc[j] += gs[tid + 256 * j - sl + 255] * uu; }
        }
#pragma unroll
        for (int j = 0; j < 4; ++j) { const int m = b * SEQ + t0 + tid + 256 * j;
            YT[(size_t)c * M + m] = (bf16)f2bf((acc[j] + bf2f(U[m]) * hb) * bf2f(X0[m])); }
    }
}
__device__ __forceinline__ void hy_norm_item(int m, int g, const bf16* YT, const float* og, bf16* A2) {
    float y[64]; float ss = 0.f;
#pragma unroll
    for (int ch = 0; ch < 64; ++ch) { y[ch] = bf2f(YT[(size_t)(g * 64 + ch) * M + m]); ss += y[ch] * y[ch]; }
    const float rs = rsqrtf(ss * (1.f / 64.f) + EPS);
#pragma unroll
    for (int ch = 0; ch < 64; ch += 8) { v4u w;
        w.x = pk2(y[ch] * rs * og[g * 64 + ch], y[ch + 1] * rs * og[g * 64 + ch + 1]); w.y = pk2(y[ch + 2] * rs * og[g * 64 + ch + 2], y[ch + 3] * rs * og[g * 64 + ch + 3]);
        w.z = pk2(y[ch + 4] * rs * og[g * 64 + ch + 4], y[ch + 5] * rs * og[g * 64 + ch + 5]); w.w = pk2(y[ch + 6] * rs * og[g * 64 + ch + 6], y[ch + 7] * rs * og[g * 64 + ch + 7]);
        *(GAS v4u*)(A2 + (size_t)m * D + 512 + g * 64 + ch) = w; }
}
__device__ __forceinline__ void final_norm_row(float* xrow, const float* gain, int lane) {
    f32x4 v[4]; float s = 0.f;
#pragma unroll
    for (int p = 0; p < 4; ++p) { v[p] = *(const GAS f32x4*)(xrow + p * 256 + lane * 4); s += (v[p].x * v[p].x + v[p].y * v[p].y) + (v[p].z * v[p].z + v[p].w * v[p].w); }
    const float rs = rsqrtf(wave_sum(s) * (1.f / D) + EPS);
#pragma unroll
    for (int p = 0; p < 4; ++p) { const f32x4 g = *(const GAS f32x4*)(gain + p * 256 + lane * 4);
        *(GAS f32x4*)(xrow + p * 256 + lane * 4) = (f32x4){v[p].x * rs * g.x, v[p].y * rs * g.y, v[p].z * rs * g.z, v[p].w * rs * g.w}; }
}

#ifndef SIMPLE_ATTN
#define SIMPLE_ATTN 0
#endif
#ifndef SIMPLE_CONV
#define SIMPLE_CONV 0
#endif
#ifndef DUPMASK
#define DUPMASK 0
#endif
#define REP(k) for (int rep_ = 0; rep_ < (((DUPMASK >> (k)) & 1) ? 2 : 1); ++rep_)
struct Args { const float* in[31]; float* out; unsigned char* ws; };
__global__ void __launch_bounds__(NWAVES * 64, 2) mega_fwd(Args args) {
    extern __shared__ __attribute__((aligned(16))) unsigned char lds[];
    Frame F;
    F.lds = (LAS unsigned char*)lds;
    F.MISC = (volatile LAS unsigned*)(F.lds + MISC_OFF);
    F.tid = threadIdx.x; F.lane = F.tid & 63; F.wave = __builtin_amdgcn_readfirstlane(F.tid >> 6);
    F.G = gridDim.x; { const int bx = blockIdx.x; F.vcu = (F.G % 8 == 0) ? (bx % 8) * (F.G / 8) + bx / 8 : bx; }
    unsigned char* ws = args.ws; unsigned char* dob = (unsigned char*)args.out;
    F.ctl = (gu32*)(ws + WS_CTL);
    const float* const* in = args.in;
    for (int u = F.tid; u < (LDS_BYTES - LDSCTL_OFF) / 4; u += NWAVES * 64) ((LAS unsigned*)(F.lds + LDSCTL_OFF))[u] = 0u;
    __syncthreads();
    XcdBarrier bar = xcd_barrier_post((unsigned*)(F.ctl + CW_BAR), F.MISC + 8);
#define GRID_BAR() xcd_barrier(bar)
    bf16 *Wgu1 = (bf16*)(ws + WS_WGU1), *Wd1 = (bf16*)(ws + WS_WD1), *Win = (bf16*)(ws + WS_WIN), *Wout = (bf16*)(ws + WS_WOUT), *Wgu2 = (bf16*)(ws + WS_WGU2), *Wd2 = (bf16*)(ws + WS_WD2);
    float* ssq = (float*)(ws + WS_SSQ); bf16* G = (bf16*)(ws + WS_G);
    bf16* XB = (bf16*)(ws + WS_XB); float* X1 = (float*)(ws + WS_X1); bf16* H = (bf16*)(ws + WS_H);
    bf16 *Qb = (bf16*)(ws + WS_Q), *Kb = (bf16*)(ws + WS_K), *Vb = (bf16*)(ws + WS_V), *A2 = (bf16*)(ws + WS_A2);
    bf16* ZT = (bf16*)(dob + DO_ZT); bf16* YT = (bf16*)(dob + DO_YT);

    REP(0) p0_early(F, in, ws);
    GRID_BAR();
    REP(1) { pg8::Gemm g{XB, Wgu1, M, 2 * FF, D}; pg8::StaticOrder S; S.init(M, 2 * FF, F.G, (int)blockIdx.x);
      pg8::EpiSwiglu E{H, FF, ssq};
      pg8::gemm_phase<pg8::EpiSwiglu, pg8::StaticOrder, true, true>(F.lds + RING_OFF, g, S, E); }
    REP(7) { const int nwg = (M / 256) * (2 * FF / 256), nfull = nwg % F.G;
      if (nfull == 0) p0_late(F, in, ws, (int)blockIdx.x, F.G); else if ((int)blockIdx.x >= nfull) p0_late(F, in, ws, (int)blockIdx.x - nfull, F.G - nfull); }
    GRID_BAR();
    REP(2) { pg8::Gemm g{H, Wd1, M, D, FF}; pg8::StaticOrder S; S.init(M, D, F.G, (int)blockIdx.x);
      pg8::EpiResid E{in[0], X1, XB, ssq, 0.5f};
      pg8::gemm_phase<pg8::EpiResid, pg8::StaticOrder, false, true>(F.lds + RING_OFF, g, S, E); }
    GRID_BAR();
    REP(3) { pg8::Gemm g{XB, Win, M, 1536, D}; pg8::StaticOrder S; S.init(M, 1536, F.G, (int)blockIdx.x);
      pg8::EpiQKV E{Qb, (size_t)(WS_K - WS_Q) / 2, ssq, C2};
      pg8::gemm_phase<pg8::EpiQKV, pg8::StaticOrder, true, true>(F.lds + RING_OFF, g, S, E); }
    __syncthreads();
    { pg8::Gemm g{Win + (size_t)1536 * D, XB, 1536, M, D}; pg8::StaticOrder S; S.init(1536, M, F.G, (int)blockIdx.x);
      pg8::EpiZT E{ZT, M, ssq};
      pg8::gemm_phase<pg8::EpiZT, pg8::StaticOrder, true, true>(F.lds + RING_OFF, g, S, E); }
    GRID_BAR();
#if SIMPLE_ATTN
    for (int vb = 2 * F.vcu + (F.tid >> 8); vb < BATCH * NH * (SEQ / 32); vb += 2 * F.G) attn_simple_pair(F, vb, Qb, Kb, Vb, in, A2);
#else
    REP(4) { float s1 = 0.f, s2 = 0.f;
      for (int i = 0; i < 64; ++i) { s1 += in[8][i] * in[9][i]; s2 += in[10][i] * in[11][i]; }
      const float lam = expf(s1) - expf(s2) + 0.2f;
      for (int u = F.vcu; u < 256; u += F.G) att::attn_unit<8>(F.lds + RING_OFF, u >> 7, (u >> 5) & 3, u & 31, Qb, Kb, Vb, in[1], lam, in[12], (float*)(ws + WS_XB), A2); }
#endif
#if SIMPLE_CONV
    for (int c = F.vcu; c < 512; c += F.G) hyena_simple_channel(F, c, ZT, G, in, YT);
#else
    REP(6) for (int c = F.vcu; c < 512; c += F.G) hyc::conv_channel(F.lds + RING_OFF, c, ZT, G, in[13], in[14], in[23][c], YT);
#endif
    GRID_BAR();
    REP(5) for (int it = F.vcu * 512 + F.tid; it < M * 8; it += F.G * 512) hy_norm_item(it % M, it / M, YT, in[24], A2);
    GRID_BAR();
    { pg8::Gemm g{A2, Wout, M, D, D}; pg8::StaticOrder S; S.init(M, D, F.G, (int)blockIdx.x);
      pg8::EpiResid E{X1, X1, XB, ssq, 1.0f};
      pg8::gemm_phase<pg8::EpiResid, pg8::StaticOrder, false, true>(F.lds + RING_OFF, g, S, E); }
    GRID_BAR();
    { pg8::Gemm g{XB, Wgu2, M, 2 * FF, D}; pg8::StaticOrder S; S.init(M, 2 * FF, F.G, (int)blockIdx.x);
      pg8::EpiSwiglu E{H, FF, ssq};
      pg8::gemm_phase<pg8::EpiSwiglu, pg8::StaticOrder, true, true>(F.lds + RING_OFF, g, S, E); }
    GRID_BAR();
    { pg8::Gemm g{H, Wd2, M, D, FF}; pg8::StaticOrder S; S.init(M, D, F.G, (int)blockIdx.x);
      pg8::EpiResid E{X1, args.out, nullptr, nullptr, 0.5f};
      pg8::gemm_phase<pg8::EpiResid, pg8::StaticOrder, false, true>(F.lds + RING_OFF, g, S, E); }
    GRID_BAR();
    { const int gw = F.vcu * NWAVES + F.wave, NGW = F.G * NWAVES;
      for (int m = gw; m < M; m += NGW) final_norm_row(args.out + (size_t)m * D, in[30], F.lane); }
}

extern "C" void kernel_launch(void* const* d_in, const int* in_sizes, int n_in, void* d_out, int out_size, void* d_ws, size_t ws_size, hipStream_t stream) {
    static int grid = 0;
    if (grid == 0) {
        if (n_in != 31 || in_sizes[0] != M * D || out_size != M * D || ws_size < WS_END) { fprintf(stderr, "kernel_launch: unexpected shapes (n_in %d, ws %zu); nothing launched\n", n_in, ws_size); grid = -1; return; }
        int dev = 0, cus = 0, per_cu = 0;
        if (hipGetDevice(&dev) != hipSuccess || hipDeviceGetAttribute(&cus, hipDeviceAttributeMultiprocessorCount, dev) != hipSuccess) { grid = -1; return; }
        if (hipFuncSetAttribute((const void*)mega_fwd, hipFuncAttributeMaxDynamicSharedMemorySize, LDS_BYTES) != hipSuccess) { fprintf(stderr, "kernel_launch: hipFuncSetAttribute failed\n"); grid = -1; return; }
        if (hipOccupancyMaxActiveBlocksPerMultiprocessor(&per_cu, (const void*)mega_fwd, NWAVES * 64, LDS_BYTES) != hipSuccess || per_cu < 1)
            fprintf(stderr, "kernel_launch: note: occupancy query reports %d workgroups per CU\n", per_cu);
        (void)hipGetLastError();
        grid = cus;
        if (grid != 256) fprintf(stderr, "kernel_launch: %d CUs; the residual GEMM phases need exactly 256 workgroups\n", grid);
    }
    if (grid < 0) return;
    (void)hipMemsetAsync((char*)d_ws + WS_CTL, 0, CTL_ZERO_BYTES, stream);
    Args a{};
    for (int i = 0; i < 31; ++i) a.in[i] = (const float*)d_in[i];
    a.out = (float*)d_out; a.ws = (unsigned char*)d_ws;
    hipLaunchKernelGGL(mega_fwd, dim3(grid), dim3(NWAVES * 64), LDS_BYTES, stream, a);
}
```

```cpp
#include <hip/hip_runtime.h>
#include <cstdio>
#include <cstdint>
#include <cmath>
namespace pg8 {
#define PG8_LAS __attribute__((address_space(3)))
typedef unsigned short bf16_t;
typedef short bf16x8 __attribute__((ext_vector_type(8)));
typedef float f32x4 __attribute__((ext_vector_type(4)));
typedef unsigned u32x4 __attribute__((ext_vector_type(4)));
constexpr int BM = 256, BK = 64, HALF = 128, HTB = HALF * BK * 2  , STAGE_BYTES = 8 * HTB, NXCD = 8, WGM = 8;

__host__ __device__ __forceinline__ int lds_byte(int r, int c) { const int st = (r >> 4) * 2 + (c >> 5), rr = r & 15, cc = c & 31, ob = rr * 64 + cc * 2; return st * 1024 + (ob ^ (((ob >> 9) & 1) << 5)); }
__host__ __device__ __forceinline__ void stage_rc(int b, int& R, int& C) { const int st = b / 1024, sb = b % 1024, swz = sb ^ (((sb >> 9) & 1) << 5); R = (st >> 1) * 16 + swz / 64; C = (st & 1) * 32 + (swz % 64) / 2; }
__host__ __device__ __forceinline__ int perm32(int rho) { const int n = rho >> 4, i = rho & 15; return 8 * (i >> 2) + 4 * n + (i & 3); }

struct Unit { int pm, pn; };
struct Gemm { const bf16_t* A; const bf16_t* Bt; int M, N, K; };

struct StaticOrder {
    int nM, nN, nwg, G, c;
    __host__ __device__ void init(int M, int N, int G_, int c_) { nM = M / BM; nN = N / BM; nwg = nM * nN; G = G_; c = c_; }
    __host__ __device__ bool next(int i, Unit& u) const {
        const long L = (long)i * G + c; if (L >= nwg) return false;
        int wgid = (int)L; { const int q = nwg / NXCD, r = nwg % NXCD, xcd = wgid % NXCD, off = wgid / NXCD; wgid = (xcd < r ? xcd * (q + 1) : r * (q + 1) + (xcd - r) * q) + off; }
        const int nig = WGM * nN, gid = wgid / nig, fm = gid * WGM, gsz = (nM - fm) < WGM ? (nM - fm) : WGM;
        u.pm = fm + ((wgid % nig) % gsz); u.pn = (wgid % nig) / gsz; return true;
    }
    __device__ __forceinline__ void a_ready(const Unit&) const {}
    __device__ __forceinline__ void done(const Unit&) const {}
};

__device__ __forceinline__ unsigned cvt_pk_bf16(float lo, float hi) { unsigned r; asm volatile("v_cvt_pk_bf16_f32 %0, %1, %2" : "=v"(r) : "v"(lo), "v"(hi)); return r; }
constexpr float RMS_EPS = 1e-6f;
__device__ __forceinline__ float rstd_row(const float* ssq, int row) { const f32x4 s = *(const f32x4*)(ssq + (size_t)row * 4); return __builtin_amdgcn_rsqf(((s[0] + s[1]) + (s[2] + s[3])) * (1.0f / 1024.0f) + RMS_EPS); }
__device__ __forceinline__ float silu_mul(float g, float u) { return g * __builtin_amdgcn_rcpf(1.0f + __builtin_amdgcn_exp2f(-1.4426950408889634f * g)) * u; }

struct EpiSwiglu {
    static constexpr bool PERM = true, AFTER_DRAIN = false;
    bf16_t* H; int ldh; const float* ssq;
    __device__ __forceinline__ void operator()(const f32x4 (&acc)[2][2][4][2], const Unit& u, int wr, int wc, int fr, int fq) const {
        const int row0 = u.pm * BM + wr * 64 + fr, col0 = u.pn * HALF + wc * 32 + 8 * fq;
#pragma unroll
        for (int ai = 0; ai < 2; ++ai)
#pragma unroll
            for (int m = 0; m < 4; ++m) { const int row = row0 + ai * HALF + m * 16; const float rs = rstd_row(ssq, row);
                const f32x4 g0 = acc[ai][0][m][0] * rs, g1 = acc[ai][0][m][1] * rs, u0 = acc[ai][1][m][0] * rs, u1 = acc[ai][1][m][1] * rs;
                u32x4 w; w.x = cvt_pk_bf16(silu_mul(g0[0], u0[0]), silu_mul(g0[1], u0[1])); w.y = cvt_pk_bf16(silu_mul(g0[2], u0[2]), silu_mul(g0[3], u0[3]));
                w.z = cvt_pk_bf16(silu_mul(g1[0], u1[0]), silu_mul(g1[1], u1[1])); w.w = cvt_pk_bf16(silu_mul(g1[2], u1[2]), silu_mul(g1[3], u1[3]));
                *(u32x4*)(H + (size_t)row * ldh + col0) = w; }
    }
};
struct EpiQKV {
    static constexpr bool PERM = true, AFTER_DRAIN = false;
    bf16_t* Q; size_t qkv_stride; const float* ssq; float qscale;
    __device__ __forceinline__ void operator()(const f32x4 (&acc)[2][2][4][2], const Unit& u, int wr, int wc, int fr, int fq) const {
        const int row0 = u.pm * BM + wr * 64 + fr; const int t = u.pn >> 1; bf16_t* base = Q + (size_t)t * qkv_stride; const float sc = t == 0 ? qscale : 1.0f;
        const int col0 = (u.pn & 1) * BM + wc * 32 + 8 * fq;
#pragma unroll
        for (int ai = 0; ai < 2; ++ai)
#pragma unroll
            for (int m = 0; m < 4; ++m) { const int row = row0 + ai * HALF + m * 16; const float rs = rstd_row(ssq, row) * sc;
#pragma unroll
                for (int bj = 0; bj < 2; ++bj) { const f32x4 v0 = acc[ai][bj][m][0] * rs, v1 = acc[ai][bj][m][1] * rs;
                    u32x4 w; w.x = cvt_pk_bf16(v0[0], v0[1]); w.y = cvt_pk_bf16(v0[2], v0[3]); w.z = cvt_pk_bf16(v1[0], v1[1]); w.w = cvt_pk_bf16(v1[2], v1[3]);
                    *(u32x4*)(base + (size_t)row * 512 + col0 + bj * HALF) = w; } }
    }
};
struct EpiZT {
    static constexpr bool PERM = true, AFTER_DRAIN = false;
    bf16_t* ZT; int ldz; const float* ssq;
    __device__ __forceinline__ void operator()(const f32x4 (&acc)[2][2][4][2], const Unit& u, int wr, int wc, int fr, int fq) const {
        const int row0 = u.pm * BM + wr * 64 + fr, col0 = u.pn * BM + wc * 32 + 8 * fq;
#pragma unroll
        for (int bj = 0; bj < 2; ++bj) { float cs[8];
#pragma unroll
            for (int j = 0; j < 8; ++j) cs[j] = rstd_row(ssq, col0 + bj * HALF + j);
#pragma unroll
            for (int ai = 0; ai < 2; ++ai)
#pragma unroll
                for (int m = 0; m < 4; ++m) { const int row = row0 + ai * HALF + m * 16; const f32x4 v0 = acc[ai][bj][m][0], v1 = acc[ai][bj][m][1];
                    u32x4 w; w.x = cvt_pk_bf16(v0[0] * cs[0], v0[1] * cs[1]); w.y = cvt_pk_bf16(v0[2] * cs[2], v0[3] * cs[3]);
                    w.z = cvt_pk_bf16(v1[0] * cs[4], v1[1] * cs[5]); w.w = cvt_pk_bf16(v1[2] * cs[6], v1[3] * cs[7]);
                    *(u32x4*)(ZT + (size_t)row * ldz + col0 + bj * HALF) = w; }
            asm volatile("" ::: "memory"); }
    }
};
struct EpiResid {
    static constexpr bool PERM = false, AFTER_DRAIN = true;
    const float* Xin; float* Xout; bf16_t* XB; float* ssq; float scale;
    __device__ __forceinline__ void fused(f32x4 (&acc)[2][2][4][2], const Unit& u, int wr, int wc, int fr, int fq, PG8_LAS unsigned char* lds, int wid, int lane) const {
        typedef unsigned u32x2v __attribute__((ext_vector_type(2)));
        PG8_LAS float* P = (PG8_LAS float*)lds;
        const int col0 = u.pn * BM + wc * 32 + 4 * fq;
#pragma unroll
        for (int ai = 0; ai < 2; ++ai)
#pragma unroll
            for (int m = 0; m < 4; ++m) { const int r = ai * HALF + wr * 64 + m * 16 + fr; const size_t off = (size_t)(u.pm * BM + r) * 1024 + col0; float ss = 0.f;
#pragma unroll
                for (int bj = 0; bj < 2; ++bj)
#pragma unroll
                    for (int n = 0; n < 2; ++n) { const size_t o = off + bj * HALF + n * 16; const f32x4 v = *(const f32x4*)(Xin + o) + acc[ai][bj][m][n] * scale;
                        *(f32x4*)(Xout + o) = v; ss += (v[0] * v[0] + v[1] * v[1]) + (v[2] * v[2] + v[3] * v[3]);
                        if (XB) { u32x2v w; w.x = cvt_pk_bf16(v[0], v[1]); w.y = cvt_pk_bf16(v[2], v[3]); *(u32x2v*)(XB + o) = w; } }
                ss += __shfl_xor(ss, 16); ss += __shfl_xor(ss, 32);
                if (fq == 0) P[r * 4 + wc] = ss;
                if (m & 1) asm volatile("" ::: "memory"); }
        asm volatile("s_waitcnt lgkmcnt(0)" ::: "memory"); __builtin_amdgcn_s_barrier(); asm volatile("" ::: "memory");
        if (ssq) { const int row = wid * 64 + lane; if (row < 256) { const f32x4 p = *(const PG8_LAS f32x4*)(P + row * 4); ssq[(size_t)(u.pm * BM + row) * 4 + u.pn] = (p[0] + p[1]) + (p[2] + p[3]); } }
        asm volatile("s_waitcnt lgkmcnt(0)" ::: "memory"); __builtin_amdgcn_s_barrier(); asm volatile("" ::: "memory");
    }
};

template <class Epi, class Sched, bool ALIGN_EPI = false, bool SP2 = false>
__device__ __forceinline__ void gemm_phase(PG8_LAS unsigned char* lds, const Gemm g, const Sched& S, const Epi& E) {
    int tid_ = threadIdx.x; asm volatile("" : "+v"(tid_));
    const int tid = tid_, wid = __builtin_amdgcn_readfirstlane(tid >> 6), lane = tid & 63, wr = wid >> 2, wc = wid & 3, fr = lane & 15, fq = lane >> 4;
    const int K = g.K, nt = K / BK;
    unsigned voffA[2], voffB[2];
#pragma unroll
    for (int i = 0; i < 2; ++i) { int R, C; stage_rc(tid * 16 + i * 8192, R, C); const int Rb = Epi::PERM ? ((R & ~31) + perm32(R & 31)) : R;
        voffA[i] = (unsigned)(R * K + C) * 2u; voffB[i] = (unsigned)(Rb * K + C) * 2u; }
    const size_t kstep = (size_t)(BK * 2);
    const size_t hstep = (size_t)HALF * K * 2;
    const size_t tstep = 2 * hstep;
    const unsigned ldsw = (unsigned)wid * 1024u;
    const int aoff = lds_byte(wr * 64 + fr, fq * 8), boff = lds_byte(wc * 32 + fr, fq * 8);
#define PG8_SA(b, h) (((b) * 2 + (h)) * HTB)
#define PG8_SB(b, h) ((4 + (b) * 2 + (h)) * HTB)
#define PG8_STAGE(bufoff, gbase, voff) do { _Pragma("unroll") for (int _i = 0; _i < 2; ++_i) \
        __builtin_amdgcn_global_load_lds((const unsigned*)((const char*)(gbase) + (voff)[_i]), (PG8_LAS unsigned*)(lds + (bufoff) + ldsw + _i * 8192), 16, 0, 0); } while (0)
#define PG8_LDA(dst, b, h) do { _Pragma("unroll") for (int m = 0; m < 4; ++m) _Pragma("unroll") for (int k = 0; k < 2; ++k) dst[m][k] = *(const PG8_LAS bf16x8*)(lds + PG8_SA(b, h) + aoff + m * 2048 + k * 1024); } while (0)
#define PG8_LDB(dst, b, h) do { _Pragma("unroll") for (int n = 0; n < 2; ++n) _Pragma("unroll") for (int k = 0; k < 2; ++k) dst[n][k] = *(const PG8_LAS bf16x8*)(lds + PG8_SB(b, h) + boff + n * 2048 + k * 1024); } while (0)
#define PG8_MMA(ai, bj, At, Bt) do { __builtin_amdgcn_s_setprio(1); _Pragma("unroll") for (int m = 0; m < 4; ++m) _Pragma("unroll") for (int n = 0; n < 2; ++n) _Pragma("unroll") for (int k = 0; k < 2; ++k) \
        acc[ai][bj][m][n] = __builtin_amdgcn_mfma_f32_16x16x32_bf16(Bt[n][k], At[m][k], acc[ai][bj][m][n], 0, 0, 0); __builtin_amdgcn_s_setprio(0); } while (0)
#define PG8_WAIT_V(n) asm volatile("s_waitcnt vmcnt(" #n ")" ::: "memory")
#define PG8_WAIT_L(n) asm volatile("s_waitcnt lgkmcnt(" #n ")" ::: "memory")
#define PG8_BAR __builtin_amdgcn_s_barrier()
#define PG8_SCHED __builtin_amdgcn_sched_barrier(0)
    Unit cur, nxt; int ui = 0;
    if (!S.next(0, cur)) return;
    f32x4 acc[2][2][4][2];
#pragma unroll
    for (int a = 0; a < 2; ++a)
#pragma unroll
        for (int b = 0; b < 2; ++b)
#pragma unroll
            for (int m = 0; m < 4; ++m)
#pragma unroll
                for (int n = 0; n < 2; ++n) acc[a][b][m][n] = (f32x4){0.f, 0.f, 0.f, 0.f};
    bf16x8 At[4][2], B0[2][2], B1[2][2];
    const char* cA = (const char*)g.A + (size_t)cur.pm * tstep; const char* cB = (const char*)g.Bt + (size_t)cur.pn * tstep;
    S.a_ready(cur);
    if constexpr (SP2) {
        PG8_STAGE(PG8_SB(0, 0), cB, voffB); PG8_STAGE(PG8_SB(0, 1), cB + hstep, voffB); PG8_STAGE(PG8_SA(0, 0), cA, voffA); PG8_STAGE(PG8_SA(0, 1), cA + hstep, voffA);
        if (wr == 1) PG8_BAR;
        PG8_WAIT_V(2); PG8_BAR;
        PG8_STAGE(PG8_SB(1, 0), cB + kstep, voffB); PG8_STAGE(PG8_SA(1, 0), cA + kstep, voffA); PG8_STAGE(PG8_SB(1, 1), cB + hstep + kstep, voffB);
        PG8_WAIT_V(6); PG8_BAR;
    } else {
        PG8_STAGE(PG8_SB(0, 0), cB, voffB); PG8_STAGE(PG8_SA(0, 0), cA, voffA); PG8_STAGE(PG8_SB(0, 1), cB + hstep, voffB); PG8_STAGE(PG8_SA(0, 1), cA + hstep, voffA);
        if (wr == 1) PG8_BAR;
        PG8_WAIT_V(4); PG8_BAR;
        PG8_STAGE(PG8_SB(1, 0), cB + kstep, voffB); PG8_STAGE(PG8_SA(1, 0), cA + kstep, voffA); PG8_STAGE(PG8_SB(1, 1), cB + hstep + kstep, voffB);
        PG8_WAIT_V(6); PG8_BAR;
    }
    for (;;) {
        const bool has_next = S.next(ui + 1, nxt);
        const char* nA = has_next ? (const char*)g.A + (size_t)nxt.pm * tstep : cA; const char* nB = has_next ? (const char*)g.Bt + (size_t)nxt.pn * tstep : cB;
        for (int t = 0; t < nt; t += 2) {
            const bool last = (t == nt - 2);
            const char* a1 = cA + (size_t)(t + 1) * kstep;
            const char* a2 = last ? nA : cA + (size_t)(t + 2) * kstep; const char* b2 = last ? nB : cB + (size_t)(t + 2) * kstep;
            const char* a3 = a2 + kstep; const char* b3 = b2 + kstep;
            if (last && has_next) S.a_ready(nxt);
            if constexpr (SP2) {
            PG8_LDB(B0, 0, 0); PG8_LDB(B1, 0, 1); PG8_SCHED; PG8_LDA(At, 0, 0); PG8_STAGE(PG8_SA(1, 1), a1 + hstep, voffA);
            PG8_WAIT_V(8); PG8_WAIT_L(0); PG8_BAR; PG8_MMA(0, 0, At, B0); PG8_MMA(0, 1, At, B1); PG8_BAR; PG8_SCHED;
            PG8_LDA(At, 0, 1); PG8_STAGE(PG8_SB(0, 0), b2, voffB); PG8_STAGE(PG8_SB(0, 1), b2 + hstep, voffB); PG8_STAGE(PG8_SA(0, 0), a2, voffA);
            PG8_WAIT_V(8); PG8_WAIT_L(0); PG8_BAR; PG8_MMA(1, 0, At, B0); PG8_MMA(1, 1, At, B1); PG8_BAR; PG8_SCHED;
            PG8_LDB(B0, 1, 0); PG8_LDB(B1, 1, 1); PG8_SCHED; PG8_LDA(At, 1, 0); PG8_STAGE(PG8_SA(0, 1), a2 + hstep, voffA);
            PG8_WAIT_V(8); PG8_WAIT_L(0); PG8_BAR; PG8_MMA(0, 0, At, B0); PG8_MMA(0, 1, At, B1); PG8_BAR; PG8_SCHED;
            PG8_LDA(At, 1, 1); PG8_STAGE(PG8_SB(1, 0), b3, voffB); PG8_STAGE(PG8_SB(1, 1), b3 + hstep, voffB); PG8_STAGE(PG8_SA(1, 0), a3, voffA);
            PG8_WAIT_V(8); PG8_WAIT_L(0); PG8_BAR; PG8_MMA(1, 0, At, B0); PG8_MMA(1, 1, At, B1); PG8_BAR; PG8_SCHED;
            } else {
            PG8_LDB(B0, 0, 0); PG8_SCHED; PG8_LDA(At, 0, 0); PG8_STAGE(PG8_SA(1, 1), a1 + hstep, voffA);
            PG8_WAIT_L(8); PG8_BAR; PG8_WAIT_L(0); PG8_MMA(0, 0, At, B0); PG8_BAR; PG8_SCHED;
            PG8_LDB(B1, 0, 1); PG8_STAGE(PG8_SB(0, 0), b2, voffB);
            PG8_BAR; PG8_WAIT_L(0); PG8_MMA(0, 1, At, B1); PG8_BAR;
            PG8_LDA(At, 0, 1); PG8_STAGE(PG8_SA(0, 0), a2, voffA);
            PG8_BAR; PG8_WAIT_L(0); PG8_MMA(1, 0, At, B0); PG8_BAR; PG8_SCHED;
            PG8_STAGE(PG8_SB(0, 1), b2 + hstep, voffB);
            PG8_WAIT_V(6); PG8_BAR; PG8_MMA(1, 1, At, B1); PG8_BAR;
            PG8_LDB(B0, 1, 0); PG8_SCHED; PG8_LDA(At, 1, 0); PG8_STAGE(PG8_SA(0, 1), a2 + hstep, voffA);
            PG8_WAIT_L(8); PG8_BAR; PG8_WAIT_L(0); PG8_MMA(0, 0, At, B0); PG8_BAR; PG8_SCHED;
            PG8_LDB(B1, 1, 1); PG8_STAGE(PG8_SB(1, 0), b3, voffB);
            PG8_BAR; PG8_WAIT_L(0); PG8_MMA(0, 1, At, B1); PG8_BAR;
            PG8_LDA(At, 1, 1); PG8_STAGE(PG8_SA(1, 0), a3, voffA);
            PG8_BAR; PG8_WAIT_L(0); PG8_MMA(1, 0, At, B0); PG8_BAR; PG8_SCHED;
            PG8_STAGE(PG8_SB(1, 1), b3 + hstep, voffB);
            PG8_WAIT_V(6); PG8_BAR; PG8_MMA(1, 1, At, B1); PG8_BAR;
            }
        }
        if constexpr (ALIGN_EPI) { if (wr == 0) PG8_BAR; }
        if constexpr (!Epi::AFTER_DRAIN) { E(acc, cur, wr, wc, fr, fq); S.done(cur); }
        if (!has_next) break;
#pragma unroll
        for (int a = 0; a < 2; ++a)
#pragma unroll
            for (int b = 0; b < 2; ++b)
#pragma unroll
                for (int m = 0; m < 4; ++m)
#pragma unroll
                    for (int n = 0; n < 2; ++n) acc[a][b][m][n] = (f32x4){0.f, 0.f, 0.f, 0.f};
        cur = nxt; cA = nA; cB = nB; ++ui;
        if constexpr (ALIGN_EPI) { if (wr == 1) PG8_BAR; }
    }
    PG8_WAIT_V(0);
    if constexpr (!ALIGN_EPI) { if (wr == 0) PG8_BAR; }
    PG8_BAR;
    if constexpr (Epi::AFTER_DRAIN) { E.fused(acc, cur, wr, wc, fr, fq, lds, wid, lane); S.done(cur); }
#undef PG8_SA
#undef PG8_SB
#undef PG8_STAGE
#undef PG8_LDA
#undef PG8_LDB
#undef PG8_MMA
#undef PG8_WAIT_V
#undef PG8_WAIT_L
#undef PG8_BAR
#undef PG8_SCHED
}
}
#define GAS __attribute__((address_space(1)))
#define LAS __attribute__((address_space(3)))
typedef unsigned short bf16;
typedef unsigned v4u __attribute__((ext_vector_type(4)));
typedef float f32x4 __attribute__((ext_vector_type(4)));
typedef short bf16x8 __attribute__((ext_vector_type(8)));
typedef GAS unsigned gu32;
typedef GAS unsigned long long gu64;
#define RLX_AGENT __ATOMIC_RELAXED, __HIP_MEMORY_SCOPE_AGENT
#define LDS_WAIT() asm volatile("s_waitcnt lgkmcnt(0)" ::: "memory")
#define VM_WAIT() asm volatile("s_waitcnt vmcnt(0)" ::: "memory")
__device__ __forceinline__ unsigned long long rt() { return __builtin_amdgcn_s_memrealtime(); }
__device__ __forceinline__ unsigned f2bf(float f) { unsigned u = __builtin_bit_cast(unsigned, f); return (u + 0x7fffu + ((u >> 16) & 1u)) >> 16; }
__device__ __forceinline__ unsigned pk2(float lo, float hi) { return f2bf(lo) | (f2bf(hi) << 16); }

#define XB_TMO      128
#define XB_XCNT(j)  (256  + 64 * (j))
#define XB_XSUB(j)  (1280 + 64 * (j))
#define XB_XGEN(j)  (2304 + 64 * (j))
#define XB_TOP      3328
#define XB_TOPGEN   3392
#define XCD_BAR_WORDS 3456
#define XB_SPIN_CAP (1u << 18)

__device__ __forceinline__ unsigned xb_ld(unsigned* p)              { return __hip_atomic_load(p, __ATOMIC_RELAXED, __HIP_MEMORY_SCOPE_AGENT); }
__device__ __forceinline__ unsigned xb_add(unsigned* p, unsigned v) { return __hip_atomic_fetch_add(p, v, __ATOMIC_RELAXED, __HIP_MEMORY_SCOPE_AGENT); }
__device__ __forceinline__ unsigned xb_xcc_id() { return (unsigned)__builtin_amdgcn_s_getreg((3 << 11) | 20) & 0xFu; }
#define XB_SPIN(cond, bar) do { unsigned _sp = 0; while (cond) { __builtin_amdgcn_s_sleep(1); \
    if ((++_sp & 255u) == 0u) { if (xb_ld(&(bar)[XB_TMO])) break; if (_sp > XB_SPIN_CAP) { atomicAdd(&(bar)[XB_TMO], 1u); break; } } } } while (0)

struct XcdBarrier {
    unsigned* bar; unsigned x;
    volatile LAS unsigned* st;
};

__device__ __forceinline__ XcdBarrier xcd_barrier_post(unsigned* bar, volatile LAS unsigned* st) {
    XcdBarrier b; b.bar = bar; b.x = xb_xcc_id(); b.st = st;
    if (threadIdx.x == 0) (void)xb_add(&bar[XB_XCNT(b.x)], 1u);
    return b;
}
__device__ __forceinline__ void xcd_barrier_complete(unsigned* bar, unsigned x, unsigned& nloc, unsigned& nx) {
    const unsigned G = gridDim.x * gridDim.y * gridDim.z;
    unsigned sum, cnt, mine, sp = 0u;
    for (;;) {
        sum = 0u; cnt = 0u; mine = 0u;
#pragma unroll
        for (unsigned j = 0; j < 16; ++j) { const unsigned c = xb_ld(&bar[XB_XCNT(j)]); sum += c; cnt += (c > 0u) ? 1u : 0u; mine = (j == x) ? c : mine; }
        if (sum == G) break;
        __builtin_amdgcn_s_sleep(1);
        if ((++sp & 255u) == 0u) { if (xb_ld(&bar[XB_TMO])) break; if (sp > XB_SPIN_CAP) { atomicAdd(&bar[XB_TMO], 1u); break; } }
    }
    nloc = mine > 0u ? mine : 1u; nx = cnt > 0u ? cnt : 1u;
}

__device__ __forceinline__ void xcd_barrier(const XcdBarrier& b) {
    asm volatile("s_waitcnt vmcnt(0)" ::: "memory");
    __syncthreads();
    if (threadIdx.x == 0) {
        unsigned* bar = b.bar;
        __builtin_amdgcn_s_waitcnt(0);
        unsigned nloc = b.st[0], nx = b.st[1];
        if (nloc == 0u) { xcd_barrier_complete(bar, b.x, nloc, nx); b.st[0] = nloc; b.st[1] = nx; }
        const unsigned old = xb_add(&bar[XB_XSUB(b.x)], 1u);
        const unsigned gen = old / nloc;
        if (old + 1u == (gen + 1u) * nloc) {
            __builtin_amdgcn_fence(__ATOMIC_RELEASE, "agent");
            asm volatile("s_waitcnt vmcnt(0)" ::: "memory");
            const unsigned og = xb_add(&bar[XB_TOP], 1u);
            const unsigned tg = og / nx;
            if (og + 1u == (tg + 1u) * nx) xb_add(&bar[XB_TOPGEN], 1u);
            else XB_SPIN(xb_ld(&bar[XB_TOPGEN]) == tg, bar);
            __builtin_amdgcn_fence(__ATOMIC_ACQUIRE, "agent");
            xb_add(&bar[XB_XGEN(b.x)], 1u);
            asm volatile("s_waitcnt vmcnt(0)" ::: "memory");
        } else {
            XB_SPIN(xb_ld(&bar[XB_XGEN(b.x)]) == gen, bar);
            __builtin_amdgcn_fence(__ATOMIC_ACQUIRE, "agent");
            asm volatile("s_waitcnt vmcnt(0)" ::: "memory");
        }
    }
    __syncthreads();
}

namespace att {
#define ATT_LAS __attribute__((address_space(3)))
typedef short bf16x8 __attribute__((ext_vector_type(8)));
typedef short s16x4 __attribute__((ext_vector_type(4)));
typedef short v4i16_t __attribute__((ext_vector_type(4)));
typedef float f32x16 __attribute__((ext_vector_type(16)));
typedef unsigned u32x4 __attribute__((ext_vector_type(4)));
typedef unsigned short bf16_t;
constexpr int SEQ = 8192, NT = SEQ / 64;
constexpr int KSLOT = 8192, VSLOT = 16384;
constexpr int L_K = 0, L_V = 2 * KSLOT, L_WS = L_V + 2 * VSLOT, L_BT = L_WS + 8 * 64 * 4, L_OST = L_BT + 2048, L_END = L_OST + 8 * 8192;
static_assert(L_END <= 131072, "attention LDS map");
__device__ __forceinline__ int crow(int r, int hi) { return (r & 3) + 8 * (r >> 2) + 4 * hi; }
__device__ __forceinline__ unsigned cvtpk(float lo, float hi) { typedef float f2 __attribute__((ext_vector_type(2))); typedef __bf16 b2 __attribute__((ext_vector_type(2))); f2 v = {lo, hi}; b2 b = __builtin_convertvector(v, b2); return __builtin_bit_cast(unsigned, b); }
__device__ __forceinline__ s16x4 vtr(const ATT_LAS unsigned char* p) { return __builtin_bit_cast(s16x4, __builtin_amdgcn_ds_read_tr16_b64_v4i16((ATT_LAS v4i16_t*)p)); }
__device__ __forceinline__ int t5_bucket(int rel) {
    const int n = rel < 0 ? -rel : rel; int b;
    if (n < 8) b = n; else if (n < 12) b = 8; else if (n < 16) b = 9; else if (n < 23) b = 10; else if (n < 32) b = 11;
    else if (n < 46) b = 12; else if (n < 64) b = 13; else if (n < 91) b = 14; else b = 15;
    return b + (rel > 0 ? 16 : 0);
}
#define ATT_WAIT_BAR() asm volatile("s_waitcnt vmcnt(0) lgkmcnt(0)\n\ts_barrier" ::: "memory")
#define ATT_MFMA(a, b, c) __builtin_amdgcn_mfma_f32_32x32x16_bf16((a), (b), (c), 0, 0, 0)

template <int THRL>
__device__ __forceinline__ void attn_unit(ATT_LAS unsigned char* lds, int b, int h, int qb, const bf16_t* Q, const bf16_t* K, const bf16_t* V, const float* rel_bias,
                                          float lam, const float* subln, float* stash, bf16_t* A2) {
    int tid_ = threadIdx.x; asm volatile("" : "+v"(tid_));
    const int tid = tid_, lane = tid & 63, r32 = lane & 31, hi = lane >> 5; const int wid = __builtin_amdgcn_readfirstlane(tid >> 6);
    const size_t rowbase = (size_t)b * SEQ; const int q0 = qb * 256 + wid * 32;
    ATT_LAS float* wsf = (ATT_LAS float*)(lds + L_WS) + wid * 64;
    ATT_LAS float* btab = (ATT_LAS float*)(lds + L_BT);
    __syncthreads();
    for (int i = tid; i < 257; i += 512) btab[i] = rel_bias[t5_bucket(i - 128) * 4 + h] * 1.4426950408889634f;
    __syncthreads();
    const float bl = btab[0], br = btab[256];
    const unsigned ldsw = (unsigned)wid * 1024u;
    const unsigned vpiece = (unsigned)(((wid >> 2) * 4 + (wid & 3)) * 1024);
    const int vrd = ((lane >> 4) & 1) * 32 + (lane & 3) * 8 + (4 * hi + ((lane & 15) >> 2)) * 64;
    const int krd = hi * 1024 + r32 * 16;
#pragma unroll 1
    for (int c = 0; c < 2; ++c) {
        const bf16_t* Qw = Q + (rowbase + q0) * 512 + h * 128 + c * 64;
        const bf16_t* ksrc = K + rowbase * 512 + h * 128 + c * 64 + (size_t)lane * 512 + wid * 8;
        const bf16_t* vsrc = V + rowbase * 512 + h * 128 + (size_t)(16 * (wid & 3) + (lane >> 2)) * 512 + (wid >> 2) * 32 + (lane & 3) * 8;
#define ATT_DMA(t, s) do { \
        __builtin_amdgcn_global_load_lds((const unsigned*)(ksrc + (size_t)(t) * 64 * 512), (ATT_LAS unsigned*)(lds + L_K + (s) * KSLOT + ldsw), 16, 0, 0); \
        __builtin_amdgcn_global_load_lds((const unsigned*)(vsrc + (size_t)(t) * 64 * 512), (ATT_LAS unsigned*)(lds + L_V + (s) * VSLOT + vpiece), 16, 0, 0); \
        __builtin_amdgcn_global_load_lds((const unsigned*)(vsrc + (size_t)(t) * 64 * 512 + 64), (ATT_LAS unsigned*)(lds + L_V + (s) * VSLOT + vpiece + 8192), 16, 0, 0); } while (0)
        __syncthreads();
        ATT_DMA(0, 0);
        bf16x8 qr[4];
#pragma unroll
        for (int d0 = 0; d0 < 4; ++d0) qr[d0] = *(const bf16x8*)(Qw + (size_t)r32 * 512 + d0 * 16 + hi * 8);
        f32x16 o[4];
#pragma unroll
        for (int d0 = 0; d0 < 4; ++d0)
#pragma unroll
            for (int r = 0; r < 16; ++r) o[d0][r] = 0.f;
        float mhat = 0.f, l_reg = 0.f; bool init_done = false;
#pragma unroll 1
        for (int t = 0; t < NT; ++t) {
            const int s = t & 1;
            ATT_WAIT_BAR();
            if (t + 1 < NT) ATT_DMA(t + 1, s ^ 1);
            const ATT_LAS unsigned char* kp = lds + L_K + s * KSLOT + krd;
            bf16x8 kf[8];
#pragma unroll
            for (int d0 = 0; d0 < 4; ++d0) { kf[2 * d0] = *(const ATT_LAS bf16x8*)(kp + d0 * 2048); kf[2 * d0 + 1] = *(const ATT_LAS bf16x8*)(kp + d0 * 2048 + 512); }
            f32x16 p0, p1;
            const int k0 = t * 64, rlo = k0 - (q0 + 31), rhi = k0 + 63 - q0;
            for (;;) {
                if (rhi <= -91 || rlo >= 91) { const float cv = (rhi <= -91 ? bl : br) - mhat;
#pragma unroll
                    for (int r = 0; r < 16; ++r) { p0[r] = cv; p1[r] = cv; } }
                else { const int dq = k0 + 4 * hi - (q0 + r32);
#pragma unroll
                    for (int r = 0; r < 16; ++r) { int d = dq + (r & 3) + 8 * (r >> 2); int d1 = d + 32;
                        d = d < -128 ? -128 : (d > 128 ? 128 : d); d1 = d1 < -128 ? -128 : (d1 > 128 ? 128 : d1);
                        p0[r] = btab[d + 128] - mhat; p1[r] = btab[d1 + 128] - mhat; } }
#pragma unroll
                for (int d0 = 0; d0 < 4; ++d0) { p0 = ATT_MFMA(kf[2 * d0], qr[d0], p0); p1 = ATT_MFMA(kf[2 * d0 + 1], qr[d0], p1); }
                float rm;
                { float a = fmaxf(fmaxf(p0[0], p0[1]), p1[0]), bq = fmaxf(fmaxf(p0[2], p0[3]), p1[1]); a = fmaxf(fmaxf(a, p1[2]), p1[3]);
#pragma unroll
                  for (int r = 4; r < 16; r += 4) { a = fmaxf(fmaxf(a, p0[r]), p0[r + 1]); bq = fmaxf(fmaxf(bq, p0[r + 2]), p0[r + 3]); a = fmaxf(fmaxf(a, p1[r]), p1[r + 1]); bq = fmaxf(fmaxf(bq, p1[r + 2]), p1[r + 3]); }
                  rm = fmaxf(a, bq); auto rr = __builtin_amdgcn_permlane32_swap(__float_as_uint(rm), __float_as_uint(rm), false, false); rm = fmaxf(__uint_as_float(rr[0]), __uint_as_float(rr[1])); }
                if (!init_done) { mhat = rm; init_done = true; continue; }
                if (!__any(rm > (float)THRL)) break;
                const float dl = fmaxf(rm, 0.f); mhat += dl;
                const float f = __builtin_amdgcn_exp2f(-dl); l_reg *= f; if (hi == 0) wsf[r32] = f;
                asm volatile("s_waitcnt lgkmcnt(0)" ::: "memory");
                float frs[16];
#pragma unroll
                for (int r = 0; r < 16; ++r) frs[r] = wsf[crow(r, hi)];
#pragma unroll
                for (int d0 = 0; d0 < 4; ++d0)
#pragma unroll
                    for (int r = 0; r < 16; ++r) o[d0][r] *= frs[r];
                asm volatile("s_waitcnt lgkmcnt(0)" ::: "memory");
            }
            float sacc = 0.f;
#pragma unroll
            for (int r = 0; r < 16; ++r) { p0[r] = __builtin_amdgcn_exp2f(p0[r]); p1[r] = __builtin_amdgcn_exp2f(p1[r]); sacc += p0[r] + p1[r]; }
            l_reg += sacc;
            u32x4 pw[4];
#pragma unroll
            for (int j = 0; j < 4; ++j) { pw[0][j] = cvtpk(p0[2 * j], p0[2 * j + 1]); pw[1][j] = cvtpk(p0[8 + 2 * j], p0[9 + 2 * j]); pw[2][j] = cvtpk(p1[2 * j], p1[2 * j + 1]); pw[3][j] = cvtpk(p1[8 + 2 * j], p1[9 + 2 * j]); }
            __builtin_amdgcn_sched_barrier(0);
            const ATT_LAS unsigned char* vp = lds + L_V + s * VSLOT + vrd;
#pragma unroll
            for (int d0 = 0; d0 < 4; ++d0) {
                s16x4 vl[4], vh[4];
#pragma unroll
                for (int ks = 0; ks < 4; ++ks) { vl[ks] = vtr(vp + d0 * 4096 + ks * 1024); vh[ks] = vtr(vp + d0 * 4096 + ks * 1024 + 512); }
#pragma unroll
                for (int ks = 0; ks < 4; ++ks) { const bf16x8 vf = (bf16x8){vl[ks][0], vl[ks][1], vl[ks][2], vl[ks][3], vh[ks][0], vh[ks][1], vh[ks][2], vh[ks][3]};
                    o[d0] = ATT_MFMA(__builtin_bit_cast(bf16x8, pw[ks]), vf, o[d0]); }
                __builtin_amdgcn_sched_barrier(0);
            }
        }
        { auto rr = __builtin_amdgcn_permlane32_swap(__float_as_uint(l_reg), __float_as_uint(l_reg), false, false); l_reg = __uint_as_float(rr[0]) + __uint_as_float(rr[1]); }
        if (hi == 0) wsf[32 + r32] = l_reg;
        asm volatile("s_waitcnt lgkmcnt(0)" ::: "memory");
        float rli[16];
#pragma unroll
        for (int r = 0; r < 16; ++r) rli[r] = __builtin_amdgcn_rcpf(wsf[32 + crow(r, hi)]);
        asm volatile("s_waitcnt lgkmcnt(0)" ::: "memory");
        size_t sbase = (rowbase + q0 + 4 * hi) * 512 + h * 128 + r32; asm volatile("" : "+v"(sbase));
        float* st = stash + sbase;
        if (c == 0) {
#pragma unroll
            for (int r = 0; r < 16; ++r)
#pragma unroll
                for (int d0 = 0; d0 < 4; ++d0) st[(size_t)((r & 3) + 8 * (r >> 2)) * 512 + d0 * 32] = o[d0][r] * rli[r];
        } else {
#ifndef NO_EPI1
            float ss[16];
#pragma unroll
            for (int r = 0; r < 16; ++r) { float sq = 0.f;
#pragma unroll
                for (int d0 = 0; d0 < 4; ++d0) { const float dv = st[(size_t)((r & 3) + 8 * (r >> 2)) * 512 + d0 * 32] - lam * (o[d0][r] * rli[r]); o[d0][r] = dv; sq += dv * dv; }
                ss[r] = sq; if ((r & 3) == 3) asm volatile("" ::: "memory"); }
#pragma unroll
            for (int off = 1; off < 32; off <<= 1)
#pragma unroll
                for (int r = 0; r < 16; ++r) ss[r] += __shfl_xor(ss[r], off);
            float g4[4];
#pragma unroll
            for (int d0 = 0; d0 < 4; ++d0) g4[d0] = subln[d0 * 32 + r32] * 0.8f;
            ATT_LAS bf16_t* stg = (ATT_LAS bf16_t*)(lds + L_OST) + wid * 4096;
#pragma unroll
            for (int r = 0; r < 16; ++r) { const float rs = __builtin_amdgcn_rsqf(ss[r] * (1.0f / 128.0f) + 1e-6f);
#pragma unroll
                for (int d0 = 0; d0 < 4; ++d0) { const float v = o[d0][r] * rs * g4[d0]; const unsigned u = __float_as_uint(v); stg[crow(r, hi) * 128 + d0 * 32 + r32] = (bf16_t)((u + 0x7fffu + ((u >> 16) & 1u)) >> 16); } }
            asm volatile("s_waitcnt lgkmcnt(0)" ::: "memory");
            size_t obase = (rowbase + q0 + (lane >> 4)) * 1024 + h * 128 + (lane & 15) * 8; asm volatile("" : "+v"(obase));
            bf16_t* Ow = A2 + obase;
#pragma unroll
            for (int i = 0; i < 8; ++i) { const int row = i * 4 + (lane >> 4), ch = lane & 15; const u32x4 v = *(const ATT_LAS u32x4*)(stg + row * 128 + ch * 8); *(u32x4*)(Ow + (size_t)(i * 4) * 1024) = v; }
            asm volatile("s_waitcnt lgkmcnt(0)" ::: "memory");
#endif
        }
#undef ATT_DMA
    }
}
}

namespace hyc {
#define HYC_LAS __attribute__((address_space(3)))
#define HYC_GAS __attribute__((address_space(1)))
typedef short bf16x8 __attribute__((ext_vector_type(8)));
typedef bf16x8 ubf16x8 __attribute__((aligned(2)));
typedef float f32x16 __attribute__((ext_vector_type(16)));
typedef unsigned u32x4 __attribute__((ext_vector_type(4)));
typedef u32x4 u32x4a4 __attribute__((aligned(4)));
typedef unsigned short bf16_t;
constexpr int SEQ = 8192, M = 16384;
constexpr int UBLK = 144, UBOFF = 160 * UBLK;
constexpr int L_U = 0, L_T0 = 49152, L_T1 = 81920, L_F0 = 49152, L_F1 = L_F0 + 32768 + 68, L_END = L_F1 + 32768;
static_assert(2 * UBOFF <= L_T0 && (UBOFF % 256) == 0 && L_END <= 131072, "conv LDS map");
__device__ __forceinline__ float bf2f(bf16_t b) { return __builtin_bit_cast(float, (unsigned)b << 16); }
__device__ __forceinline__ unsigned f2bf(float f) { unsigned u = __builtin_bit_cast(unsigned, f); return (u + 0x7fffu + ((u >> 16) & 1u)) >> 16; }
__device__ __forceinline__ int crow(int r, int hi) { return (r & 3) + 8 * (r >> 2) + 4 * hi; }

__device__ __forceinline__ void sconv8(const HYC_LAS bf16_t* T, int m0, float w0, float w1, float w2, float bb, float (&u)[8]) {
    const u32x4 v = *(const HYC_LAS u32x4*)(T + m0);
    float z[10]; const int t = m0 & (SEQ - 1);
    z[0] = t > 0 ? bf2f(T[m0 - 1]) : 0.f; z[9] = t + 8 < SEQ ? bf2f(T[m0 + 8]) : 0.f;
#pragma unroll
    for (int j = 0; j < 4; ++j) { z[1 + 2 * j] = __builtin_bit_cast(float, v[j] << 16); z[2 + 2 * j] = __builtin_bit_cast(float, v[j] & 0xffff0000u); }
#pragma unroll
    for (int j = 0; j < 8; ++j) u[j] = bb + w0 * z[j] + w1 * z[j + 1] + w2 * z[j + 2];
}

__device__ __forceinline__ void conv_channel(HYC_LAS unsigned char* lds, int c, const bf16_t* ZT, const bf16_t* GR, const float* cw, const float* cb, float hb, bf16_t* YT) {
    int tid_ = threadIdx.x; asm volatile("" : "+v"(tid_));
    const int tid = tid_, lane = tid & 63, r32 = lane & 31, hi = lane >> 5; const int wid = __builtin_amdgcn_readfirstlane(tid >> 6);
    HYC_LAS bf16_t* T0 = (HYC_LAS bf16_t*)(lds + L_T0); HYC_LAS bf16_t* T1 = (HYC_LAS bf16_t*)(lds + L_T1);
    const bf16_t* z0row = ZT + (size_t)c * M;
    __syncthreads();
    for (int i = tid; i < M / 8; i += 512) ((HYC_LAS u32x4*)T0)[i] = ((const HYC_GAS u32x4*)z0row)[i];
    __syncthreads();
    { const float w0 = cw[c], w1 = cw[1536 + c], w2 = cw[3072 + c], bb = cb[c];
      for (int i = tid; i < M / 8; i += 512) { float u[8]; sconv8(T0, i * 8, w0, w1, w2, bb, u);
          u32x4 o; o.x = f2bf(u[0]) | (f2bf(u[1]) << 16); o.y = f2bf(u[2]) | (f2bf(u[3]) << 16); o.z = f2bf(u[4]) | (f2bf(u[5]) << 16); o.w = f2bf(u[6]) | (f2bf(u[7]) << 16);
          ((HYC_GAS u32x4*)(YT + (size_t)c * M))[i] = o; } }
    __syncthreads();
    for (int i = tid; i < M / 8; i += 512) { ((HYC_LAS u32x4*)T0)[i] = ((const HYC_GAS u32x4*)(ZT + (size_t)(512 + c) * M))[i]; ((HYC_LAS u32x4*)T1)[i] = ((const HYC_GAS u32x4*)(ZT + (size_t)(1024 + c) * M))[i]; }
    for (int i = tid; i < 2 * 2 * 16 * (UBLK / 16); i += 512) { const int b = i / (2 * 16 * 9), rem = i % (2 * 16 * 9), side = rem / (16 * 9), q = rem % (16 * 9);
        *(HYC_LAS u32x4*)(lds + L_U + b * UBOFF + side * (144 * UBLK) + q * 16) = (u32x4){0u, 0u, 0u, 0u}; }
    __syncthreads();
    { const float a0 = cw[512 + c], a1 = cw[1536 + 512 + c], a2 = cw[3072 + 512 + c], ab = cb[512 + c];
      const float v0 = cw[1024 + c], v1 = cw[1536 + 1024 + c], v2 = cw[3072 + 1024 + c], vb = cb[1024 + c];
      for (int i = tid; i < M / 8; i += 512) { float ux[8], uv[8]; sconv8(T0, i * 8, a0, a1, a2, ab, ux); sconv8(T1, i * 8, v0, v1, v2, vb, uv);
          u32x4 o; o.x = f2bf(ux[0] * uv[0]) | (f2bf(ux[1] * uv[1]) << 16); o.y = f2bf(ux[2] * uv[2]) | (f2bf(ux[3] * uv[3]) << 16);
          o.z = f2bf(ux[4] * uv[4]) | (f2bf(ux[5] * uv[5]) << 16); o.w = f2bf(ux[6] * uv[6]) | (f2bf(ux[7] * uv[7]) << 16);
          const int m0 = i * 8, b = m0 >> 13, t = m0 & (SEQ - 1);
          *(HYC_LAS u32x4*)(lds + L_U + b * UBOFF + ((t >> 6) + 16) * UBLK + (t & 63) * 2) = o; } }
    __syncthreads();
    { const bf16_t* grow = GR + (size_t)c * 16384;
      for (int i = tid; i < 16384 / 8; i += 512) { const u32x4 v = ((const HYC_GAS u32x4*)grow)[i]; const unsigned nx = ((const HYC_GAS unsigned*)grow)[4 * i + 4 < 8192 ? 4 * i + 4 : 8191];
          ((HYC_LAS u32x4*)(lds + L_F0))[i] = v;
          HYC_LAS unsigned* f1 = (HYC_LAS unsigned*)(lds + L_F1) + 4 * i;
          f1[0] = (v.x >> 16) | (v.y << 16); f1[1] = (v.y >> 16) | (v.z << 16); f1[2] = (v.z >> 16) | (v.w << 16); f1[3] = (v.w >> 16) | (nx << 16); } }
    __syncthreads();
    const int i0 = 16 * wid, dlo = i0 - 127;
    const int il = r32 & 15, bb_ = r32 >> 4;
    int aoff = L_U + bb_ * UBOFF + (i0 + il - dlo + 16) * UBLK + hi * 16;
    int goff = ((r32 & 1) ? (L_F1 - 2) : L_F0) + 2 * (8192 - (64 * dlo + r32 - 8 * hi));
#define HYC_LDF(off) __builtin_bit_cast(bf16x8, *(const HYC_LAS u32x4a4*)(lds + (off)))
    bf16x8 f0 = HYC_LDF(goff - 64), f1 = HYC_LDF(goff - 32), f2 = HYC_LDF(goff), f3 = HYC_LDF(goff + 32), f4 = HYC_LDF(goff + 64), f5 = HYC_LDF(goff + 96);
    f32x16 acc0, acc1;
#pragma unroll
    for (int r = 0; r < 16; ++r) { acc0[r] = 0.f; acc1[r] = 0.f; }
#pragma unroll 1
    for (int e = 0; e < 143; ++e) {
        const int gn = goff - (e < 142 ? 128 : 0);
        const bf16x8 n0 = HYC_LDF(gn - 64), n1 = HYC_LDF(gn - 32), n2 = HYC_LDF(gn), n3 = HYC_LDF(gn + 32);
        const bf16x8 a0 = *(const HYC_LAS bf16x8*)(lds + aoff), a1 = *(const HYC_LAS bf16x8*)(lds + aoff + 32), a2 = *(const HYC_LAS bf16x8*)(lds + aoff + 64), a3 = *(const HYC_LAS bf16x8*)(lds + aoff + 96);
        acc0 = __builtin_amdgcn_mfma_f32_32x32x16_bf16(a0, f2, acc0, 0, 0, 0); acc1 = __builtin_amdgcn_mfma_f32_32x32x16_bf16(a0, f0, acc1, 0, 0, 0);
        acc0 = __builtin_amdgcn_mfma_f32_32x32x16_bf16(a1, f3, acc0, 0, 0, 0); acc1 = __builtin_amdgcn_mfma_f32_32x32x16_bf16(a1, f1, acc1, 0, 0, 0);
        acc0 = __builtin_amdgcn_mfma_f32_32x32x16_bf16(a2, f4, acc0, 0, 0, 0); acc1 = __builtin_amdgcn_mfma_f32_32x32x16_bf16(a2, f2, acc1, 0, 0, 0);
        acc0 = __builtin_amdgcn_mfma_f32_32x32x16_bf16(a3, f5, acc0, 0, 0, 0); acc1 = __builtin_amdgcn_mfma_f32_32x32x16_bf16(a3, f3, acc1, 0, 0, 0);
        f4 = f0; f5 = f1; f0 = n0; f1 = n1; f2 = n2; f3 = n3; goff = gn; aoff -= UBLK;
    }
#undef HYC_LDF
    bf16_t* yrow = YT + (size_t)c * M;
#pragma unroll
    for (int nt = 0; nt < 2; ++nt)
#pragma unroll
        for (int r = 0; r < 16; ++r) { const int rho = crow(r, hi), i = i0 + (rho & 15), b = rho >> 4, t = 64 * i + 32 * nt + r32, m = b * SEQ + t;
            const float vx = bf2f(*(const HYC_LAS bf16_t*)(lds + L_U + b * UBOFF + (i + 16) * UBLK + (32 * nt + r32) * 2));
            const float x0 = bf2f(yrow[m]);
            const float a = nt == 0 ? acc0[r] : acc1[r];
            yrow[m] = (bf16_t)f2bf((a + vx * hb) * x0); }
}
}

constexpr int NWAVES = 8;
constexpr int BATCH = 2, SEQ = 8192, D = 1024, M = BATCH * SEQ, FF = 2816, DIN = 3072, NH = 4;
constexpr float EPS = 1e-6f;
constexpr float LOG2E = 1.4426950408889634f;
constexpr float C2 = 0.125f * LOG2E;

constexpr size_t MiB = 1u << 20;
constexpr size_t WS_CTL = 0, CTL_ZERO_BYTES = 64 * 1024;
constexpr size_t WS_WGU1 = 1 * MiB;
constexpr size_t WS_WD1 = 12 * MiB;
constexpr size_t WS_WIN = 18 * MiB;
constexpr size_t WS_WOUT = 24 * MiB;
constexpr size_t WS_WGU2 = 26 * MiB;
constexpr size_t WS_WD2 = 37 * MiB;
constexpr size_t WS_SSQ = 43 * MiB;
constexpr size_t WS_G = 46 * MiB;
constexpr size_t WS_XB = 62 * MiB;
constexpr size_t WS_X1 = 94 * MiB;
constexpr size_t WS_H = 158 * MiB;
constexpr size_t WS_Q = WS_H, WS_K = WS_H + 16 * MiB, WS_V = WS_H + 32 * MiB;
constexpr size_t WS_A2 = WS_H + 48 * MiB;
constexpr size_t WS_END = 246 * MiB;
constexpr size_t DO_ZT = 0, DO_YT = 48 * MiB;
constexpr int CW_TMO = 0, CW_BAR = 4096;

constexpr int RING_OFF = 0, RING_BYTES = 131072;
constexpr int LDSCTL_OFF = RING_BYTES, MISC_OFF = LDSCTL_OFF + 320;
constexpr int LDS_BYTES = 147456;

struct Frame {
    LAS unsigned char* lds;
    volatile LAS unsigned* MISC;
    gu32* ctl;
    int tid, lane, wave;
    int vcu, G;
};

__device__ __forceinline__ float bf2f(bf16 b) { return __builtin_bit_cast(float, (unsigned)b << 16); }
__device__ __forceinline__ float wave_sum(float v) {
#pragma unroll
    for (int o = 1; o < 64; o <<= 1) v += __shfl_xor(v, o);
    return v;
}

__device__ __forceinline__ void p0_transpose_item(const float* W, const float* gain, int K, int N, bf16* WT, int item, int mode, int up, LAS float* scr, int lane) {
    const int nblk = N / 32, kb = item / nblk, nb = item % nblk, k0 = 64 * kb, n0 = 32 * nb;
    const int dst_row0 = mode ? (256 * (n0 / 128) + (n0 % 128) + 128 * up) : n0;
    const int q = lane >> 3, c4 = (lane & 7) * 4;
    f32x4 v[8]; float g[8];
#pragma unroll
    for (int j = 0; j < 8; ++j) { v[j] = *(const GAS f32x4*)(W + (size_t)(k0 + 8 * j + q) * N + n0 + c4); g[j] = gain ? gain[k0 + 8 * j + q] : 1.0f; }
#pragma unroll
    for (int j = 0; j < 8; ++j) { LAS float* d = scr + (8 * j + q) * 33 + c4; d[0] = v[j].x * g[j]; d[1] = v[j].y * g[j]; d[2] = v[j].z * g[j]; d[3] = v[j].w * g[j]; }
    LDS_WAIT(); asm volatile("" ::: "memory");
    const int c = lane & 7;
#pragma unroll
    for (int j = 0; j < 4; ++j) { const int n = (lane >> 3) + 8 * j; const LAS float* s = scr + (8 * c) * 33 + n;
        v4u o; o.x = pk2(s[0 * 33], s[1 * 33]); o.y = pk2(s[2 * 33], s[3 * 33]); o.z = pk2(s[4 * 33], s[5 * 33]); o.w = pk2(s[6 * 33], s[7 * 33]);
        *(GAS v4u*)(WT + (size_t)(dst_row0 + n) * K + k0 + 8 * c) = o; }
    LDS_WAIT(); asm volatile("" ::: "memory");
}
__device__ __forceinline__ void row_to_bf16_ssq2(const float* x0, const float* x1, bf16* o0, bf16* o1, float* s0, float* s1, int lane) {
    f32x4 a[4], b[4];
#pragma unroll
    for (int p = 0; p < 4; ++p) { a[p] = *(const GAS f32x4*)(x0 + p * 256 + lane * 4); b[p] = *(const GAS f32x4*)(x1 + p * 256 + lane * 4); }
#pragma unroll
    for (int p = 0; p < 4; ++p) { const float sa = wave_sum((a[p].x * a[p].x + a[p].y * a[p].y) + (a[p].z * a[p].z + a[p].w * a[p].w)), sb = wave_sum((b[p].x * b[p].x + b[p].y * b[p].y) + (b[p].z * b[p].z + b[p].w * b[p].w));
        if (lane == 0) { s0[p] = sa; s1[p] = sb; }
        *(GAS unsigned long long*)(o0 + p * 256 + lane * 4) = (unsigned long long)pk2(a[p].x, a[p].y) | ((unsigned long long)pk2(a[p].z, a[p].w) << 32);
        *(GAS unsigned long long*)(o1 + p * 256 + lane * 4) = (unsigned long long)pk2(b[p].x, b[p].y) | ((unsigned long long)pk2(b[p].z, b[p].w) << 32); }
}
__device__ __forceinline__ void p0_filters_unit(Frame& F, const float* const* in, bf16* G, int u) {
    LAS float* a3s = (LAS float*)(F.lds + RING_OFF);
    const float *w1 = in[15], *b1 = in[16], *w2 = in[17], *b2 = in[18], *w3 = in[19], *b3 = in[20], *w4 = in[21], *freq = in[22];
    const int lane = F.lane; const float fr = freq[lane];
    { float aq[4];
#pragma unroll
      for (int q = 0; q < 4; ++q) { const int i = 32 * u + F.wave * 4 + q; float z = 0.f;
          const float w = (6.283185307179586f * (float)i) / (float)SEQ; const int j = (lane - 1) & 15; const float f = 1e-4f + (float)j * ((15.0f - 1e-4f) / 15.0f); const float fw = f * w;
          if (lane == 0) z = (float)i / (float)(SEQ - 1); else if (lane <= 16) z = cosf(fw); else if (lane <= 32) z = -sinf(fw);
          aq[q] = z; }
      { float r[33]; const float c1 = b1[lane];
#pragma unroll
        for (int ch = 0; ch < 3; ++ch) { const float* wc = w1 + ch * 1024 + lane; asm volatile("" : "+v"(wc));
#pragma unroll
            for (int e = 0; e < 16; ++e) if (ch * 16 + e < 33) r[ch * 16 + e] = wc[e * 64]; }
#pragma unroll
        for (int q = 0; q < 4; ++q) { float s = c1;
#pragma unroll
            for (int e = 0; e < 33; ++e) s += __shfl(aq[q], e) * r[e];
            aq[q] = sinf(fr * s); } }
      asm volatile("" ::: "memory");
#pragma unroll 1
      for (int layer = 0; layer < 2; ++layer) { const float* wl = layer ? w3 : w2; const float cb_ = (layer ? b3 : b2)[lane]; float r[64];
#pragma unroll
        for (int ch = 0; ch < 4; ++ch) { const float* wc = wl + ch * 1024 + lane; asm volatile("" : "+v"(wc));
#pragma unroll
            for (int e = 0; e < 16; ++e) r[ch * 16 + e] = wc[e * 64]; }
#pragma unroll
        for (int q = 0; q < 4; ++q) { float s = cb_;
#pragma unroll
            for (int e = 0; e < 64; ++e) s += __shfl(aq[q], e) * r[e];
            aq[q] = sinf(fr * s); }
        asm volatile("" ::: "memory"); }
#pragma unroll
      for (int q = 0; q < 4; ++q) a3s[(F.wave * 4 + q) * 64 + lane] = aq[q]; }
    __syncthreads();
    { const int c = F.tid; float acc0[32], acc1[32];
#pragma unroll
      for (int p = 0; p < 32; ++p) { acc0[p] = 0.f; acc1[p] = 0.f; }
#pragma unroll 1
      for (int k = 0; k < 64; k += 4) { float wa[4], wb[4];
#pragma unroll
          for (int kk = 0; kk < 4; ++kk) { wa[kk] = w4[(k + kk) * 1024 + c]; wb[kk] = w4[(k + kk) * 1024 + 512 + c]; }
#pragma unroll
          for (int p = 0; p < 32; ++p) { const f32x4 a = *(const LAS f32x4*)(a3s + p * 64 + k);
              acc0[p] += a.x * wa[0]; acc1[p] += a.x * wb[0]; acc0[p] += a.y * wa[1]; acc1[p] += a.y * wb[1]; acc0[p] += a.z * wa[2]; acc1[p] += a.z * wb[2]; acc0[p] += a.w * wa[3]; acc1[p] += a.w * wb[3]; } }
      const float mind = logf(1e-2f) / 1.5f, maxd = logf(1e-2f) / 0.3f; const float ad = fabsf(mind + (float)c * ((maxd - mind) / 511.0f));
      bf16* gc = G + (size_t)c * 16384 + 8192; const int i0 = 32 * u;
#pragma unroll
      for (int p8 = 0; p8 < 4; ++p8) { unsigned w[4];
#pragma unroll
          for (int h = 0; h < 4; ++h) { const int p = p8 * 8 + 2 * h; const float d0 = expf(-((float)(i0 + p) / (float)(SEQ - 1)) * ad), d1 = expf(-((float)(i0 + p + 1) / (float)(SEQ - 1)) * ad);
              const float e0 = (i0 + p == 0) ? acc0[p] : acc1[p];
              w[h] = pk2(e0 * d0, acc1[p + 1] * d1); }
          *(GAS v4u*)(gc + i0 + p8 * 8) = (v4u){w[0], w[1], w[2], w[3]}; }
#pragma unroll
      for (int p = 0; p < 32; ++p) { const int i = i0 + p; const float dd = expf(-((float)i / (float)(SEQ - 1)) * ad);
          if (i >= 1) gc[-i] = (bf16)f2bf(acc0[p] * dd); else gc[-8192] = 0; }
    }
    __syncthreads();
}

constexpr int I_GU = (D / 64) * (FF / 32), I_DN = (FF / 64) * (D / 32), I_IN = (D / 64) * (DIN / 32), I_OUT = (D / 64) * (D / 32);
constexpr int NITEMS = 4 * I_GU + 2 * I_DN + I_IN + I_OUT;
__device__ __forceinline__ void p0_transpose_range(Frame& F, const float* const* in, unsigned char* ws, int first, int last, int gw, int NGW) {
    LAS float* scr = (LAS float*)(F.lds + RING_OFF + F.wave * 16384);
    bf16 *Wgu1 = (bf16*)(ws + WS_WGU1), *Wd1 = (bf16*)(ws + WS_WD1), *Win = (bf16*)(ws + WS_WIN), *Wout = (bf16*)(ws + WS_WOUT), *Wgu2 = (bf16*)(ws + WS_WGU2), *Wd2 = (bf16*)(ws + WS_WD2);
    for (int it = first + gw; it < last; it += NGW) {
        int r = it;
        if (r < I_GU) { p0_transpose_item(in[3], in[2], D, FF, Wgu1, r, 1, 0, scr, F.lane); continue; } r -= I_GU;
        if (r < I_GU) { p0_transpose_item(in[4], in[2], D, FF, Wgu1, r, 1, 1, scr, F.lane); continue; } r -= I_GU;
        if (r < I_DN) { p0_transpose_item(in[5], nullptr, FF, D, Wd1, r, 0, 0, scr, F.lane); continue; } r -= I_DN;
        if (r < I_IN) { p0_transpose_item(in[7], in[6], D, DIN, Win, r, 0, 0, scr, F.lane); continue; } r -= I_IN;
        if (r < I_OUT) { p0_transpose_item(in[25], nullptr, D, D, Wout, r, 0, 0, scr, F.lane); continue; } r -= I_OUT;
        if (r < I_GU) { p0_transpose_item(in[27], in[26], D, FF, Wgu2, r, 1, 0, scr, F.lane); continue; } r -= I_GU;
        if (r < I_GU) { p0_transpose_item(in[28], in[26], D, FF, Wgu2, r, 1, 1, scr, F.lane); continue; } r -= I_GU;
        p0_transpose_item(in[29], nullptr, FF, D, Wd2, r, 0, 0, scr, F.lane);
    }
}
__device__ __forceinline__ void p0_early(Frame& F, const float* const* in, unsigned char* ws) {
    const int gw = F.vcu * NWAVES + F.wave, NGW = F.G * NWAVES;
    p0_transpose_range(F, in, ws, 0, 2 * I_GU, gw, NGW);
    bf16* XB = (bf16*)(ws + WS_XB); float* ssq = (float*)(ws + WS_SSQ);
    for (int m = 2 * gw; m < M; m += 2 * NGW) row_to_bf16_ssq2(in[0] + (size_t)m * D, in[0] + (size_t)(m + 1) * D, XB + (size_t)m * D, XB + (size_t)(m + 1) * D, ssq + (size_t)m * 4, ssq + (size_t)(m + 1) * 4, F.lane);
}
__device__ __forceinline__ void p0_late(Frame& F, const float* const* in, unsigned char* ws, int rank, int nranks) {
    bf16* G = (bf16*)(ws + WS_G);
    __syncthreads();
    for (int u = rank; u < SEQ / 32; u += nranks) p0_filters_unit(F, in, G, u);
    __syncthreads();
    p0_transpose_range(F, in, ws, 2 * I_GU, NITEMS, rank * NWAVES + F.wave, nranks * NWAVES);
    __syncthreads();
}

__device__ __forceinline__ int t5_bucket(int rel) {
    const int n = rel < 0 ? -rel : rel; int b;
    if (n < 8) b = n; else if (n < 12) b = 8; else if (n < 16) b = 9; else if (n < 23) b = 10; else if (n < 32) b = 11;
    else if (n < 46) b = 12; else if (n < 64) b = 13; else if (n < 91) b = 14; else b = 15;
    return b + (rel > 0 ? 16 : 0);
}

__device__ __forceinline__ void attn_simple_pair(Frame& F, int vb, const bf16* Q, const bf16* K, const bf16* V, const float* const* in, bf16* A2) {
    const int half = F.tid >> 8, tid = F.tid & 255, part = tid & 7, ql = tid >> 3;
    LAS float* Ks = (LAS float*)(F.lds + RING_OFF + half * 20480);
    LAS float* Vs = Ks + 16 * 128;
    LAS float* btab = Vs + 16 * 128;
    LAS float* lam_s = btab + 260;
    const int qblk = vb & 255, h = (vb >> 8) & 3, b = vb >> 10;
    const int qpos = qblk * 32 + ql; const size_t mrow = (size_t)b * SEQ + qpos;
    const float* rel_bias = in[1];
    __syncthreads();
    for (int i = tid; i < 257; i += 256) btab[i] = rel_bias[t5_bucket(i - 128) * NH + h] * LOG2E;
    if (tid == 0) { float s1 = 0.f, s2 = 0.f; for (int i = 0; i < 64; ++i) { s1 += in[8][i] * in[9][i]; s2 += in[10][i] * in[11][i]; } lam_s[0] = expf(s1) - expf(s2) + 0.2f; }
    float q1[8], q2[8];
#pragma unroll
    for (int d = 0; d < 8; ++d) { q1[d] = bf2f(Q[mrow * 512 + h * 128 + part * 8 + d]); q2[d] = bf2f(Q[mrow * 512 + h * 128 + 64 + part * 8 + d]); }
    float o1[16], o2[16];
#pragma unroll
    for (int e = 0; e < 16; ++e) { o1[e] = 0.f; o2[e] = 0.f; }
    float m1 = -1e30f, m2 = -1e30f, l1 = 0.f, l2 = 0.f;
    for (int k0 = 0; k0 < SEQ; k0 += 8) {
        __syncthreads();
        for (int i = tid; i < 8 * 128; i += 256) { const int kk = i >> 7, c = i & 127; const size_t kr = (size_t)b * SEQ + k0 + kk;
            Ks[kk * 128 + c] = bf2f(K[kr * 512 + h * 128 + c]); Vs[kk * 128 + c] = bf2f(V[kr * 512 + h * 128 + c]); }
        __syncthreads();
        float s1[8], s2[8]; float t1 = -1e30f, t2 = -1e30f;
#pragma unroll
        for (int j = 0; j < 8; ++j) { float a = 0.f, c = 0.f;
#pragma unroll
            for (int d = 0; d < 8; ++d) { a += q1[d] * Ks[j * 128 + part * 8 + d]; c += q2[d] * Ks[j * 128 + 64 + part * 8 + d]; }
            a += __shfl_xor(a, 1); a += __shfl_xor(a, 2); a += __shfl_xor(a, 4); c += __shfl_xor(c, 1); c += __shfl_xor(c, 2); c += __shfl_xor(c, 4);
            int rel = k0 + j - qpos; rel = rel < -128 ? -128 : (rel > 128 ? 128 : rel); const float bb = btab[rel + 128];
            a += bb; c += bb; s1[j] = a; s2[j] = c; t1 = fmaxf(t1, a); t2 = fmaxf(t2, c); }
        const float n1 = fmaxf(m1, t1), n2 = fmaxf(m2, t2); const float a1 = exp2f(m1 - n1), a2 = exp2f(m2 - n2);
        m1 = n1; m2 = n2; l1 *= a1; l2 *= a2;
#pragma unroll
        for (int e = 0; e < 16; ++e) { o1[e] *= a1; o2[e] *= a2; }
#pragma unroll
        for (int j = 0; j < 8; ++j) { const float p1 = exp2f(s1[j] - m1), p2 = exp2f(s2[j] - m2); l1 += p1; l2 += p2;
#pragma unroll
            for (int e = 0; e < 16; ++e) { const float v = Vs[j * 128 + part * 16 + e]; o1[e] += p1 * v; o2[e] += p2 * v; } }
    }
    const float lam = lam_s[0]; const float i1 = 1.f / l1, i2 = lam / l2; float ss = 0.f;
#pragma unroll
    for (int e = 0; e < 16; ++e) { o1[e] = o1[e] * i1 - o2[e] * i2; ss += o1[e] * o1[e]; }
    ss += __shfl_xor(ss, 1); ss += __shfl_xor(ss, 2); ss += __shfl_xor(ss, 4);
    const float rs = rsqrtf(ss * (1.f / 128.f) + EPS) * 0.8f; const float* subln = in[12];
#pragma unroll
    for (int e = 0; e < 16; ++e) A2[mrow * D + h * 128 + part * 16 + e] = (bf16)f2bf(o1[e] * rs * subln[part * 16 + e]);
}

__device__ __forceinline__ void hyena_simple_channel(Frame& F, int c, const bf16* ZT, const bf16* G, const float* const* in, bf16* YT) {
    LAS bf16* X0 = (LAS bf16*)(F.lds + RING_OFF);
    LAS bf16* U = (LAS bf16*)(F.lds + RING_OFF + 32768);
    LAS bf16* T0 = (LAS bf16*)(F.lds + RING_OFF + 65536);
    LAS bf16* T1 = (LAS bf16*)(F.lds + RING_OFF + 98304);
    const float* cw = in[13]; const float* cb = in[14];
    __syncthreads();
    for (int i = F.tid; i < M / 8; i += 512) ((LAS v4u*)T0)[i] = ((const GAS v4u*)(ZT + (size_t)c * M))[i];
    __syncthreads();
    { const float w0 = cw[c], w1 = cw[1536 + c], w2 = cw[3072 + c], bb = cb[c];
      for (int m = F.tid; m < M; m += 512) { const int t = m & (SEQ - 1);
          const float zm = t > 0 ? bf2f(T0[m - 1]) : 0.f, z0 = bf2f(T0[m]), zp = t < SEQ - 1 ? bf2f(T0[m + 1]) : 0.f;
          X0[m] = (bf16)f2bf(bb + w0 * zm + w1 * z0 + w2 * zp); } }
    __syncthreads();
    for (int i = F.tid; i < M / 8; i += 512) { ((LAS v4u*)T0)[i] = ((const GAS v4u*)(ZT + (size_t)(512 + c) * M))[i]; ((LAS v4u*)T1)[i] = ((const GAS v4u*)(ZT + (size_t)(1024 + c) * M))[i]; }
    __syncthreads();
    { const float a0 = cw[512 + c], a1 = cw[1536 + 512 + c], a2 = cw[3072 + 512 + c], ab = cb[512 + c];
      const float v0 = cw[1024 + c], v1 = cw[1536 + 1024 + c], v2 = cw[3072 + 1024 + c], vb = cb[1024 + c];
      for (int m = F.tid; m < M; m += 512) { const int t = m & (SEQ - 1);
          const float xm = t > 0 ? bf2f(T0[m - 1]) : 0.f, x0 = bf2f(T0[m]), xp = t < SEQ - 1 ? bf2f(T0[m + 1]) : 0.f;
          const float ym = t > 0 ? bf2f(T1[m - 1]) : 0.f, y0 = bf2f(T1[m]), yp = t < SEQ - 1 ? bf2f(T1[m + 1]) : 0.f;
          U[m] = (bf16)f2bf((ab + a0 * xm + a1 * x0 + a2 * xp) * (vb + v0 * ym + v1 * y0 + v2 * yp)); } }
    __syncthreads();
    const int half = F.tid >> 8, tid = F.tid & 255;
    LAS float* gs = (LAS float*)(F.lds + RING_OFF + 65536 + half * 8192);
    const bf16* g = G + (size_t)c * 16384 + 8192; const float hb = in[23][c];
    for (int vbk = half; vbk < 16; vbk += 2) { const int b = vbk >> 3, t0 = (vbk & 7) * 1024;
        float acc[4] = {0.f, 0.f, 0.f, 0.f};
        for (int s0 = 0; s0 < SEQ; s0 += 256) {
            __syncthreads();
            for (int i = tid; i < 1279; i += 256) { const int d = t0 - s0 - 255 + i; gs[i] = (d > -8192 && d < 8192) ? bf2f(g[-d]) : 0.f; }
            __syncthreads();
#pragma unroll 8
            for (int sl = 0; sl < 256; ++sl) { const float uu = bf2f(U[b * SEQ + s0 + sl]);
#pragma unroll
                for (int j = 0; j < 4; ++j) acc[j] += gs[tid + 256 * j - sl + 255] * uu; }
        }
#pragma unroll
        for (int j = 0; j < 4; ++j) { const int m = b * SEQ + t0 + tid + 256 * j;
            YT[(size_t)c * M + m] = (bf16)f2bf((acc[j] + bf2f(U[m]) * hb) * bf2f(X0[m])); }
    }
}
__device__ __forceinline__ void hy_norm_item(int m, int g, const bf16* YT, const float* og, bf16* A2) {
    float y[64]; float ss = 0.f;
#pragma unroll
    for (int ch = 0; ch < 64; ++ch) { y[ch] = bf2f(YT[(size_t)(g * 64 + ch) * M + m]); ss += y[ch] * y[ch]; }
    const float rs = rsqrtf(ss * (1.f / 64.f) + EPS);
#pragma unroll
    for (int ch = 0; ch < 64; ch += 8) { v4u w;
        w.x = pk2(y[ch] * rs * og[g * 64 + ch], y[ch + 1] * rs * og[g * 64 + ch + 1]); w.y = pk2(y[ch + 2] * rs * og[g * 64 + ch + 2], y[ch + 3] * rs * og[g * 64 + ch + 3]);
        w.z = pk2(y[ch + 4] * rs * og[g * 64 + ch + 4], y[ch + 5] * rs * og[g * 64 + ch + 5]); w.w = pk2(y[ch + 6] * rs * og[g * 64 + ch + 6], y[ch + 7] * rs * og[g * 64 + ch + 7]);
        *(GAS v4u*)(A2 + (size_t)m * D + 512 + g * 64 + ch) = w; }
}
__device__ __forceinline__ void final_norm_row(float* xrow, const float* gain, int lane) {
    f32x4 v[4]; float s = 0.f;
#pragma unroll
    for (int p = 0; p < 4; ++p) { v[p] = *(const GAS f32x4*)(xrow + p * 256 + lane * 4); s += (v[p].x * v[p].x + v[p].y * v[p].y) + (v[p].z * v[p].z + v[p].w * v[p].w); }
    const float rs = rsqrtf(wave_sum(s) * (1.f / D) + EPS);
#pragma unroll
    for (int p = 0; p < 4; ++p) { const f32x4 g = *(const GAS f32x4*)(gain + p * 256 + lane * 4);
        *(GAS f32x4*)(xrow + p * 256 + lane * 4) = (f32x4){v[p].x * rs * g.x, v[p].y * rs * g.y, v[p].z * rs * g.z, v[p].w * rs * g.w}; }
}

#ifndef SIMPLE_ATTN
#define SIMPLE_ATTN 0
#endif
#ifndef SIMPLE_CONV
#define SIMPLE_CONV 0
#endif
#ifndef DUPMASK
#define DUPMASK 0
#endif
#define REP(k) for (int rep_ = 0; rep_ < (((DUPMASK >> (k)) & 1) ? 2 : 1); ++rep_)
struct Args { const float* in[31]; float* out; unsigned char* ws; };
__global__ void __launch_bounds__(NWAVES * 64, 2) mega_fwd(Args args) {
    extern __shared__ __attribute__((aligned(16))) unsigned char lds[];
    Frame F;
    F.lds = (LAS unsigned char*)lds;
    F.MISC = (volatile LAS unsigned*)(F.lds + MISC_OFF);
    F.tid = threadIdx.x; F.lane = F.tid & 63; F.wave = __builtin_amdgcn_readfirstlane(F.tid >> 6);
    F.G = gridDim.x; { const int bx = blockIdx.x; F.vcu = (F.G % 8 == 0) ? (bx % 8) * (F.G / 8) + bx / 8 : bx; }
    unsigned char* ws = args.ws; unsigned char* dob = (unsigned char*)args.out;
    F.ctl = (gu32*)(ws + WS_CTL);
    const float* const* in = args.in;
    for (int u = F.tid; u < (LDS_BYTES - LDSCTL_OFF) / 4; u += NWAVES * 64) ((LAS unsigned*)(F.lds + LDSCTL_OFF))[u] = 0u;
    __syncthreads();
    XcdBarrier bar = xcd_barrier_post((unsigned*)(F.ctl + CW_BAR), F.MISC + 8);
#define GRID_BAR() xcd_barrier(bar)
#define RELAUNDER() do { int t_ = threadIdx.x; asm volatile("" : "+v"(t_)); F.tid = t_; F.lane = t_ & 63; } while (0)
    bf16 *Wgu1 = (bf16*)(ws + WS_WGU1), *Wd1 = (bf16*)(ws + WS_WD1), *Win = (bf16*)(ws + WS_WIN), *Wout = (bf16*)(ws + WS_WOUT), *Wgu2 = (bf16*)(ws + WS_WGU2), *Wd2 = (bf16*)(ws + WS_WD2);
    float* ssq = (float*)(ws + WS_SSQ); bf16* G = (bf16*)(ws + WS_G);
    bf16* XB = (bf16*)(ws + WS_XB); float* X1 = (float*)(ws + WS_X1); bf16* H = (bf16*)(ws + WS_H);
    bf16 *Qb = (bf16*)(ws + WS_Q), *Kb = (bf16*)(ws + WS_K), *Vb = (bf16*)(ws + WS_V), *A2 = (bf16*)(ws + WS_A2);
    bf16* ZT = (bf16*)(dob + DO_ZT); bf16* YT = (bf16*)(dob + DO_YT);

    RELAUNDER();
    REP(0) p0_early(F, in, ws);
    GRID_BAR();
    REP(1) { pg8::Gemm g{XB, Wgu1, M, 2 * FF, D}; pg8::StaticOrder S; S.init(M, 2 * FF, F.G, (int)blockIdx.x);
      pg8::EpiSwiglu E{H, FF, ssq};
      pg8::gemm_phase<pg8::EpiSwiglu, pg8::StaticOrder, true, true>(F.lds + RING_OFF, g, S, E); }
    RELAUNDER();
    REP(7) { const int nwg = (M / 256) * (2 * FF / 256), nfull = nwg % F.G;
      if (nfull == 0) p0_late(F, in, ws, (int)blockIdx.x, F.G); else if ((int)blockIdx.x >= nfull) p0_late(F, in, ws, (int)blockIdx.x - nfull, F.G - nfull); }
    GRID_BAR();
    REP(2) { pg8::Gemm g{H, Wd1, M, D, FF}; pg8::StaticOrder S; S.init(M, D, F.G, (int)blockIdx.x);
      pg8::EpiResid E{in[0], X1, XB, ssq, 0.5f};
      pg8::gemm_phase<pg8::EpiResid, pg8::StaticOrder, false, true>(F.lds + RING_OFF, g, S, E); }
    GRID_BAR();
    REP(3) { pg8::Gemm g{XB, Win, M, 1536, D}; pg8::StaticOrder S; S.init(M, 1536, F.G, (int)blockIdx.x);
      pg8::EpiQKV E{Qb, (size_t)(WS_K - WS_Q) / 2, ssq, C2};
      pg8::gemm_phase<pg8::EpiQKV, pg8::StaticOrder, true, true>(F.lds + RING_OFF, g, S, E); }
    __syncthreads();
    { pg8::Gemm g{Win + (size_t)1536 * D, XB, 1536, M, D}; pg8::StaticOrder S; S.init(1536, M, F.G, (int)blockIdx.x);
      pg8::EpiZT E{ZT, M, ssq};
      pg8::gemm_phase<pg8::EpiZT, pg8::StaticOrder, true, true>(F.lds + RING_OFF, g, S, E); }
    GRID_BAR();
#if SIMPLE_ATTN
    for (int vb = 2 * F.vcu + (F.tid >> 8); vb < BATCH * NH * (SEQ / 32); vb += 2 * F.G) attn_simple_pair(F, vb, Qb, Kb, Vb, in, A2);
#else
    REP(4) { float s1 = 0.f, s2 = 0.f;
      for (int i = 0; i < 64; ++i) { s1 += in[8][i] * in[9][i]; s2 += in[10][i] * in[11][i]; }
      const float lam = expf(s1) - expf(s2) + 0.2f;
      for (int u = F.vcu; u < 256; u += F.G) att::attn_unit<8>(F.lds + RING_OFF, u >> 7, (u >> 5) & 3, u & 31, Qb, Kb, Vb, in[1], lam, in[12], (float*)(ws + WS_XB), A2); }
#endif
#if SIMPLE_CONV
    for (int c = F.vcu; c < 512; c += F.G) hyena_simple_channel(F, c, ZT, G, in, YT);
#else
    RELAUNDER();
    REP(6) for (int c = F.vcu; c < 512; c += F.G) hyc::conv_channel(F.lds + RING_OFF, c, ZT, G, in[13], in[14], in[23][c], YT);
#endif
    GRID_BAR();
    RELAUNDER();
    REP(5) for (int it = F.vcu * 512 + F.tid; it < M * 8; it += F.G * 512) hy_norm_item(it % M, it / M, YT, in[24], A2);
    GRID_BAR();
    { pg8::Gemm g{A2, Wout, M, D, D}; pg8::StaticOrder S; S.init(M, D, F.G, (int)blockIdx.x);
      pg8::EpiResid E{X1, X1, XB, ssq, 1.0f};
      pg8::gemm_phase<pg8::EpiResid, pg8::StaticOrder, false, true>(F.lds + RING_OFF, g, S, E); }
    GRID_BAR();
    { pg8::Gemm g{XB, Wgu2, M, 2 * FF, D}; pg8::StaticOrder S; S.init(M, 2 * FF, F.G, (int)blockIdx.x);
      pg8::EpiSwiglu E{H, FF, ssq};
      pg8::gemm_phase<pg8::EpiSwiglu, pg8::StaticOrder, true, true>(F.lds + RING_OFF, g, S, E); }
    GRID_BAR();
    { pg8::Gemm g{H, Wd2, M, D, FF}; pg8::StaticOrder S; S.init(M, D, F.G, (int)blockIdx.x);
      pg8::EpiResid E{X1, args.out, nullptr, nullptr, 0.5f};
      pg8::gemm_phase<pg8::EpiResid, pg8::StaticOrder, false, true>(F.lds + RING_OFF, g, S, E); }
    GRID_BAR();
    RELAUNDER();
    { const int gw = F.vcu * NWAVES + F.wave, NGW = F.G * NWAVES;
      for (int m = gw; m < M; m += NGW) final_norm_row(args.out + (size_t)m * D, in[30], F.lane); }
}

extern "C" void kernel_launch(void* const* d_in, const int* in_sizes, int n_in, void* d_out, int out_size, void* d_ws, size_t ws_size, hipStream_t stream) {
    static int grid = 0;
    if (grid == 0) {
        if (n_in != 31 || in_sizes[0] != M * D || out_size != M * D || ws_size < WS_END) { fprintf(stderr, "kernel_launch: unexpected shapes (n_in %d, ws %zu); nothing launched\n", n_in, ws_size); grid = -1; return; }
        int dev = 0, cus = 0, per_cu = 0;
        if (hipGetDevice(&dev) != hipSuccess || hipDeviceGetAttribute(&cus, hipDeviceAttributeMultiprocessorCount, dev) != hipSuccess) { grid = -1; return; }
        if (hipFuncSetAttribute((const void*)mega_fwd, hipFuncAttributeMaxDynamicSharedMemorySize, LDS_BYTES) != hipSuccess) { fprintf(stderr, "kernel_launch: hipFuncSetAttribute failed\n"); grid = -1; return; }
        if (hipOccupancyMaxActiveBlocksPerMultiprocessor(&per_cu, (const void*)mega_fwd, NWAVES * 64, LDS_BYTES) != hipSuccess || per_cu < 1)
            fprintf(stderr, "kernel_launch: note: occupancy query reports %d workgroups per CU\n", per_cu);
        (void)hipGetLastError();
        grid = cus;
        if (grid != 256) fprintf(stderr, "kernel_launch: %d CUs; the residual GEMM phases need exactly 256 workgroups\n", grid);
    }
    if (grid < 0) return;
    (void)hipMemsetAsync((char*)d_ws + WS_CTL, 0, CTL_ZERO_BYTES, stream);
    Args a{};
    for (int i = 0; i < 31; ++i) a.in[i] = (const float*)d_in[i];
    a.out = (float*)d_out; a.ws = (unsigned char*)d_ws;
    hipLaunchKernelGGL(mega_fwd, dim3(grid), dim3(NWAVES * 64), LDS_BYTES, stream, a);
}
```

```cpp
#include <hip/hip_runtime.h>
#include <cstdio>
#include <cstdint>
#include <cmath>
namespace pg8 {
#define PG8_LAS __attribute__((address_space(3)))
typedef unsigned short bf16_t;
typedef short bf16x8 __attribute__((ext_vector_type(8)));
typedef float f32x4 __attribute__((ext_vector_type(4)));
typedef unsigned u32x4 __attribute__((ext_vector_type(4)));
constexpr int BM = 256, BK = 64, HALF = 128, HTB = HALF * BK * 2  , STAGE_BYTES = 8 * HTB, NXCD = 8, WGM = 8;

__host__ __device__ __forceinline__ int lds_byte(int r, int c) { const int st = (r >> 4) * 2 + (c >> 5), rr = r & 15, cc = c & 31, ob = rr * 64 + cc * 2; return st * 1024 + (ob ^ (((ob >> 9) & 1) << 5)); }
__host__ __device__ __forceinline__ void stage_rc(int b, int& R, int& C) { const int st = b / 1024, sb = b % 1024, swz = sb ^ (((sb >> 9) & 1) << 5); R = (st >> 1) * 16 + swz / 64; C = (st & 1) * 32 + (swz % 64) / 2; }
__host__ __device__ __forceinline__ int perm32(int rho) { const int n = rho >> 4, i = rho & 15; return 8 * (i >> 2) + 4 * n + (i & 3); }

struct Unit { int pm, pn; };
struct Gemm { const bf16_t* A; const bf16_t* Bt; int M, N, K; };

struct StaticOrder {
    int nM, nN, nwg, G, c;
    __host__ __device__ void init(int M, int N, int G_, int c_) { nM = M / BM; nN = N / BM; nwg = nM * nN; G = G_; c = c_; }
    __host__ __device__ bool next(int i, Unit& u) const {
        const long L = (long)i * G + c; if (L >= nwg) return false;
        int wgid = (int)L; { const int q = nwg / NXCD, r = nwg % NXCD, xcd = wgid % NXCD, off = wgid / NXCD; wgid = (xcd < r ? xcd * (q + 1) : r * (q + 1) + (xcd - r) * q) + off; }
        const int nig = WGM * nN, gid = wgid / nig, fm = gid * WGM, gsz = (nM - fm) < WGM ? (nM - fm) : WGM;
        u.pm = fm + ((wgid % nig) % gsz); u.pn = (wgid % nig) / gsz; return true;
    }
    __device__ __forceinline__ void a_ready(const Unit&) const {}
    __device__ __forceinline__ void done(const Unit&) const {}
};

__device__ __forceinline__ unsigned cvt_pk_bf16(float lo, float hi) { unsigned r; asm volatile("v_cvt_pk_bf16_f32 %0, %1, %2" : "=v"(r) : "v"(lo), "v"(hi)); return r; }
constexpr float RMS_EPS = 1e-6f;
__device__ __forceinline__ float rstd_row(const float* ssq, int row) { const f32x4 s = *(const f32x4*)(ssq + (size_t)row * 4); return __builtin_amdgcn_rsqf(((s[0] + s[1]) + (s[2] + s[3])) * (1.0f / 1024.0f) + RMS_EPS); }
__device__ __forceinline__ float silu_mul(float g, float u) { return g * __builtin_amdgcn_rcpf(1.0f + __builtin_amdgcn_exp2f(-1.4426950408889634f * g)) * u; }

struct EpiSwiglu {
    static constexpr bool PERM = true, AFTER_DRAIN = false;
    bf16_t* H; int ldh; const float* ssq;
    __device__ __forceinline__ void operator()(const f32x4 (&acc)[2][2][4][2], const Unit& u, int wr, int wc, int fr, int fq) const {
        const int row0 = u.pm * BM + wr * 64 + fr, col0 = u.pn * HALF + wc * 32 + 8 * fq;
#pragma unroll
        for (int ai = 0; ai < 2; ++ai)
#pragma unroll
            for (int m = 0; m < 4; ++m) { const int row = row0 + ai * HALF + m * 16; const float rs = rstd_row(ssq, row);
                const f32x4 g0 = acc[ai][0][m][0] * rs, g1 = acc[ai][0][m][1] * rs, u0 = acc[ai][1][m][0] * rs, u1 = acc[ai][1][m][1] * rs;
                u32x4 w; w.x = cvt_pk_bf16(silu_mul(g0[0], u0[0]), silu_mul(g0[1], u0[1])); w.y = cvt_pk_bf16(silu_mul(g0[2], u0[2]), silu_mul(g0[3], u0[3]));
                w.z = cvt_pk_bf16(silu_mul(g1[0], u1[0]), silu_mul(g1[1], u1[1])); w.w = cvt_pk_bf16(silu_mul(g1[2], u1[2]), silu_mul(g1[3], u1[3]));
                *(u32x4*)(H + (size_t)row * ldh + col0) = w; }
    }
};
struct EpiQKV {
    static constexpr bool PERM = true, AFTER_DRAIN = false;
    bf16_t* Q; size_t qkv_stride; const float* ssq; float qscale;
    __device__ __forceinline__ void operator()(const f32x4 (&acc)[2][2][4][2], const Unit& u, int wr, int wc, int fr, int fq) const {
        const int row0 = u.pm * BM + wr * 64 + fr; const int t = u.pn >> 1; bf16_t* base = Q + (size_t)t * qkv_stride; const float sc = t == 0 ? qscale : 1.0f;
        const int col0 = (u.pn & 1) * BM + wc * 32 + 8 * fq;
#pragma unroll
        for (int ai = 0; ai < 2; ++ai)
#pragma unroll
            for (int m = 0; m < 4; ++m) { const int row = row0 + ai * HALF + m * 16; const float rs = rstd_row(ssq, row) * sc;
#pragma unroll
                for (int bj = 0; bj < 2; ++bj) { const f32x4 v0 = acc[ai][bj][m][0] * rs, v1 = acc[ai][bj][m][1] * rs;
                    u32x4 w; w.x = cvt_pk_bf16(v0[0], v0[1]); w.y = cvt_pk_bf16(v0[2], v0[3]); w.z = cvt_pk_bf16(v1[0], v1[1]); w.w = cvt_pk_bf16(v1[2], v1[3]);
                    *(u32x4*)(base + (size_t)row * 512 + col0 + bj * HALF) = w; } }
    }
};
struct EpiZT {
    static constexpr bool PERM = true, AFTER_DRAIN = false;
    bf16_t* ZT; int ldz; const float* ssq;
    __device__ __forceinline__ void operator()(const f32x4 (&acc)[2][2][4][2], const Unit& u, int wr, int wc, int fr, int fq) const {
        const int row0 = u.pm * BM + wr * 64 + fr, col0 = u.pn * BM + wc * 32 + 8 * fq;
#pragma unroll
        for (int bj = 0; bj < 2; ++bj) { float cs[8];
#pragma unroll
            for (int j = 0; j < 8; ++j) cs[j] = rstd_row(ssq, col0 + bj * HALF + j);
#pragma unroll
            for (int ai = 0; ai < 2; ++ai)
#pragma unroll
                for (int m = 0; m < 4; ++m) { const int row = row0 + ai * HALF + m * 16; const f32x4 v0 = acc[ai][bj][m][0], v1 = acc[ai][bj][m][1];
                    u32x4 w; w.x = cvt_pk_bf16(v0[0] * cs[0], v0[1] * cs[1]); w.y = cvt_pk_bf16(v0[2] * cs[2], v0[3] * cs[3]);
                    w.z = cvt_pk_bf16(v1[0] * cs[4], v1[1] * cs[5]); w.w = cvt_pk_bf16(v1[2] * cs[6], v1[3] * cs[7]);
                    *(u32x4*)(ZT + (size_t)row * ldz + col0 + bj * HALF) = w; }
            asm volatile("" ::: "memory"); }
    }
};
struct EpiResid {
    static constexpr bool PERM = false, AFTER_DRAIN = true;
    const float* Xin; float* Xout; bf16_t* XB; float* ssq; float scale;
    __device__ __forceinline__ void fused(f32x4 (&acc)[2][2][4][2], const Unit& u, int wr, int wc, int fr, int fq, PG8_LAS unsigned char* lds, int wid, int lane) const {
        typedef unsigned u32x2v __attribute__((ext_vector_type(2)));
        PG8_LAS float* P = (PG8_LAS float*)lds;
        const int col0 = u.pn * BM + wc * 32 + 4 * fq;
#pragma unroll
        for (int ai = 0; ai < 2; ++ai)
#pragma unroll
            for (int m = 0; m < 4; ++m) { const int r = ai * HALF + wr * 64 + m * 16 + fr; const size_t off = (size_t)(u.pm * BM + r) * 1024 + col0; float ss = 0.f;
#pragma unroll
                for (int bj = 0; bj < 2; ++bj)
#pragma unroll
                    for (int n = 0; n < 2; ++n) { const size_t o = off + bj * HALF + n * 16; const f32x4 v = *(const f32x4*)(Xin + o) + acc[ai][bj][m][n] * scale;
                        *(f32x4*)(Xout + o) = v; ss += (v[0] * v[0] + v[1] * v[1]) + (v[2] * v[2] + v[3] * v[3]);
                        if (XB) { u32x2v w; w.x = cvt_pk_bf16(v[0], v[1]); w.y = cvt_pk_bf16(v[2], v[3]); *(u32x2v*)(XB + o) = w; } }
                ss += __shfl_xor(ss, 16); ss += __shfl_xor(ss, 32);
                if (fq == 0) P[r * 4 + wc] = ss;
                if (m & 1) asm volatile("" ::: "memory"); }
        asm volatile("s_waitcnt lgkmcnt(0)" ::: "memory"); __builtin_amdgcn_s_barrier(); asm volatile("" ::: "memory");
        if (ssq) { const int row = wid * 64 + lane; if (row < 256) { const f32x4 p = *(const PG8_LAS f32x4*)(P + row * 4); ssq[(size_t)(u.pm * BM + row) * 4 + u.pn] = (p[0] + p[1]) + (p[2] + p[3]); } }
        asm volatile("s_waitcnt lgkmcnt(0)" ::: "memory"); __builtin_amdgcn_s_barrier(); asm volatile("" ::: "memory");
    }
};

template <class Epi, class Sched, bool ALIGN_EPI = false, bool SP2 = false>
__device__ __forceinline__ void gemm_phase(PG8_LAS unsigned char* lds, const Gemm g, const Sched& S, const Epi& E) {
    int tid_ = threadIdx.x; asm volatile("" : "+v"(tid_));
    const int tid = tid_, wid = __builtin_amdgcn_readfirstlane(tid >> 6), lane = tid & 63, wr = wid >> 2, wc = wid & 3, fr = lane & 15, fq = lane >> 4;
    const int K = g.K, nt = K / BK;
    unsigned voffA[2], voffB[2];
#pragma unroll
    for (int i = 0; i < 2; ++i) { int R, C; stage_rc(tid * 16 + i * 8192, R, C); const int Rb = Epi::PERM ? ((R & ~31) + perm32(R & 31)) : R;
        voffA[i] = (unsigned)(R * K + C) * 2u; voffB[i] = (unsigned)(Rb * K + C) * 2u; }
    const size_t kstep = (size_t)(BK * 2);
    const size_t hstep = (size_t)HALF * K * 2;
    const size_t tstep = 2 * hstep;
    const unsigned ldsw = (unsigned)wid * 1024u;
    const int aoff = lds_byte(wr * 64 + fr, fq * 8), boff = lds_byte(wc * 32 + fr, fq * 8);
#define PG8_SA(b, h) (((b) * 2 + (h)) * HTB)
#define PG8_SB(b, h) ((4 + (b) * 2 + (h)) * HTB)
#define PG8_STAGE(bufoff, gbase, voff) do { _Pragma("unroll") for (int _i = 0; _i < 2; ++_i) \
        __builtin_amdgcn_global_load_lds((const unsigned*)((const char*)(gbase) + (voff)[_i]), (PG8_LAS unsigned*)(lds + (bufoff) + ldsw + _i * 8192), 16, 0, 0); } while (0)
#define PG8_LDA(dst, b, h) do { _Pragma("unroll") for (int m = 0; m < 4; ++m) _Pragma("unroll") for (int k = 0; k < 2; ++k) dst[m][k] = *(const PG8_LAS bf16x8*)(lds + PG8_SA(b, h) + aoff + m * 2048 + k * 1024); } while (0)
#define PG8_LDB(dst, b, h) do { _Pragma("unroll") for (int n = 0; n < 2; ++n) _Pragma("unroll") for (int k = 0; k < 2; ++k) dst[n][k] = *(const PG8_LAS bf16x8*)(lds + PG8_SB(b, h) + boff + n * 2048 + k * 1024); } while (0)
#define PG8_MMA(ai, bj, At, Bt) do { __builtin_amdgcn_s_setprio(1); _Pragma("unroll") for (int m = 0; m < 4; ++m) _Pragma("unroll") for (int n = 0; n < 2; ++n) _Pragma("unroll") for (int k = 0; k < 2; ++k) \
        acc[ai][bj][m][n] = __builtin_amdgcn_mfma_f32_16x16x32_bf16(Bt[n][k], At[m][k], acc[ai][bj][m][n], 0, 0, 0); __builtin_amdgcn_s_setprio(0); } while (0)
#define PG8_WAIT_V(n) asm volatile("s_waitcnt vmcnt(" #n ")" ::: "memory")
#define PG8_WAIT_L(n) asm volatile("s_waitcnt lgkmcnt(" #n ")" ::: "memory")
#define PG8_BAR __builtin_amdgcn_s_barrier()
#define PG8_SCHED __builtin_amdgcn_sched_barrier(0)
    Unit cur, nxt; int ui = 0;
    if (!S.next(0, cur)) return;
    f32x4 acc[2][2][4][2];
#pragma unroll
    for (int a = 0; a < 2; ++a)
#pragma unroll
        for (int b = 0; b < 2; ++b)
#pragma unroll
            for (int m = 0; m < 4; ++m)
#pragma unroll
                for (int n = 0; n < 2; ++n) acc[a][b][m][n] = (f32x4){0.f, 0.f, 0.f, 0.f};
    bf16x8 At[4][2], B0[2][2], B1[2][2];
    const char* cA = (const char*)g.A + (size_t)cur.pm * tstep; const char* cB = (const char*)g.Bt + (size_t)cur.pn * tstep;
    S.a_ready(cur);
    if constexpr (SP2) {
        PG8_STAGE(PG8_SB(0, 0), cB, voffB); PG8_STAGE(PG8_SB(0, 1), cB + hstep, voffB); PG8_STAGE(PG8_SA(0, 0), cA, voffA); PG8_STAGE(PG8_SA(0, 1), cA + hstep, voffA);
        if (wr == 1) PG8_BAR;
        PG8_WAIT_V(2); PG8_BAR;
        PG8_STAGE(PG8_SB(1, 0), cB + kstep, voffB); PG8_STAGE(PG8_SA(1, 0), cA + kstep, voffA); PG8_STAGE(PG8_SB(1, 1), cB + hstep + kstep, voffB);
        PG8_WAIT_V(6); PG8_BAR;
    } else {
        PG8_STAGE(PG8_SB(0, 0), cB, voffB); PG8_STAGE(PG8_SA(0, 0), cA, voffA); PG8_STAGE(PG8_SB(0, 1), cB + hstep, voffB); PG8_STAGE(PG8_SA(0, 1), cA + hstep, voffA);
        if (wr == 1) PG8_BAR;
        PG8_WAIT_V(4); PG8_BAR;
        PG8_STAGE(PG8_SB(1, 0), cB + kstep, voffB); PG8_STAGE(PG8_SA(1, 0), cA + kstep, voffA); PG8_STAGE(PG8_SB(1, 1), cB + hstep + kstep, voffB);
        PG8_WAIT_V(6); PG8_BAR;
    }
    for (;;) {
        const bool has_next = S.next(ui + 1, nxt);
        const char* nA = has_next ? (const char*)g.A + (size_t)nxt.pm * tstep : cA; const char* nB = has_next ? (const char*)g.Bt + (size_t)nxt.pn * tstep : cB;
        for (int t = 0; t < nt; t += 2) {
            const bool last = (t == nt - 2);
            const char* a1 = cA + (size_t)(t + 1) * kstep;
            const char* a2 = last ? nA : cA + (size_t)(t + 2) * kstep; const char* b2 = last ? nB : cB + (size_t)(t + 2) * kstep;
            const char* a3 = a2 + kstep; const char* b3 = b2 + kstep;
            if (last && has_next) S.a_ready(nxt);
            if constexpr (SP2) {
            PG8_LDB(B0, 0, 0); PG8_LDB(B1, 0, 1); PG8_SCHED; PG8_LDA(At, 0, 0); PG8_STAGE(PG8_SA(1, 1), a1 + hstep, voffA);
            PG8_WAIT_V(8); PG8_WAIT_L(0); PG8_BAR; PG8_MMA(0, 0, At, B0); PG8_MMA(0, 1, At, B1); PG8_BAR; PG8_SCHED;
            PG8_LDA(At, 0, 1); PG8_STAGE(PG8_SB(0, 0), b2, voffB); PG8_STAGE(PG8_SB(0, 1), b2 + hstep, voffB); PG8_STAGE(PG8_SA(0, 0), a2, voffA);
            PG8_WAIT_V(8); PG8_WAIT_L(0); PG8_BAR; PG8_MMA(1, 0, At, B0); PG8_MMA(1, 1, At, B1); PG8_BAR; PG8_SCHED;
            PG8_LDB(B0, 1, 0); PG8_LDB(B1, 1, 1); PG8_SCHED; PG8_LDA(At, 1, 0); PG8_STAGE(PG8_SA(0, 1), a2 + hstep, voffA);
            PG8_WAIT_V(8); PG8_WAIT_L(0); PG8_BAR; PG8_MMA(0, 0, At, B0); PG8_MMA(0, 1, At, B1); PG8_BAR; PG8_SCHED;
            PG8_LDA(At, 1, 1); PG8_STAGE(PG8_SB(1, 0), b3, voffB); PG8_STAGE(PG8_SB(1, 1), b3 + hstep, voffB); PG8_STAGE(PG8_SA(1, 0), a3, voffA);
            PG8_WAIT_V(8); PG8_WAIT_L(0); PG8_BAR; PG8_MMA(1, 0, At, B0); PG8_MMA(1, 1, At, B1); PG8_BAR; PG8_SCHED;
            } else {
            PG8_LDB(B0, 0, 0); PG8_SCHED; PG8_LDA(At, 0, 0); PG8_STAGE(PG8_SA(1, 1), a1 + hstep, voffA);
            PG8_WAIT_L(8); PG8_BAR; PG8_WAIT_L(0); PG8_MMA(0, 0, At, B0); PG8_BAR; PG8_SCHED;
            PG8_LDB(B1, 0, 1); PG8_STAGE(PG8_SB(0, 0), b2, voffB);
            PG8_BAR; PG8_WAIT_L(0); PG8_MMA(0, 1, At, B1); PG8_BAR;
            PG8_LDA(At, 0, 1); PG8_STAGE(PG8_SA(0, 0), a2, voffA);
            PG8_BAR; PG8_WAIT_L(0); PG8_MMA(1, 0, At, B0); PG8_BAR; PG8_SCHED;
            PG8_STAGE(PG8_SB(0, 1), b2 + hstep, voffB);
            PG8_WAIT_V(6); PG8_BAR; PG8_MMA(1, 1, At, B1); PG8_BAR;
            PG8_LDB(B0, 1, 0); PG8_SCHED; PG8_LDA(At, 1, 0); PG8_STAGE(PG8_SA(0, 1), a2 + hstep, voffA);
            PG8_WAIT_L(8); PG8_BAR; PG8_WAIT_L(0); PG8_MMA(0, 0, At, B0); PG8_BAR; PG8_SCHED;
            PG8_LDB(B1, 1, 1); PG8_STAGE(PG8_SB(1, 0), b3, voffB);
            PG8_BAR; PG8_WAIT_L(0); PG8_MMA(0, 1, At, B1); PG8_BAR;
            PG8_LDA(At, 1, 1); PG8_STAGE(PG8_SA(1, 0), a3, voffA);
            PG8_BAR; PG8_WAIT_L(0); PG8_MMA(1, 0, At, B0); PG8_BAR; PG8_SCHED;
            PG8_STAGE(PG8_SB(1, 1), b3 + hstep, voffB);
            PG8_WAIT_V(6); PG8_BAR; PG8_MMA(1, 1, At, B1); PG8_BAR;
            }
        }
        if constexpr (ALIGN_EPI) { if (wr == 0) PG8_BAR; }
        if constexpr (!Epi::AFTER_DRAIN) { E(acc, cur, wr, wc, fr, fq); S.done(cur); }
        if (!has_next) break;
#pragma unroll
        for (int a = 0; a < 2; ++a)
#pragma unroll
            for (int b = 0; b < 2; ++b)
#pragma unroll
                for (int m = 0; m < 4; ++m)
#pragma unroll
                    for (int n = 0; n < 2; ++n) acc[a][b][m][n] = (f32x4){0.f, 0.f, 0.f, 0.f};
        cur = nxt; cA = nA; cB = nB; ++ui;
        if constexpr (ALIGN_EPI) { if (wr == 1) PG8_BAR; }
    }
    PG8_WAIT_V(0);
    if constexpr (!ALIGN_EPI) { if (wr == 0) PG8_BAR; }
    PG8_BAR;
    if constexpr (Epi::AFTER_DRAIN) { E.fused(acc, cur, wr, wc, fr, fq, lds, wid, lane); S.done(cur); }
#undef PG8_SA
#undef PG8_SB
#undef PG8_STAGE
#undef PG8_LDA
#undef PG8_LDB
#undef PG8_MMA
#undef PG8_WAIT_V
#undef PG8_WAIT_L
#undef PG8_BAR
#undef PG8_SCHED
}
}
#define GAS __attribute__((address_space(1)))
#define LAS __attribute__((address_space(3)))
typedef unsigned short bf16;
typedef unsigned v4u __attribute__((ext_vector_type(4)));
typedef float f32x4 __attribute__((ext_vector_type(4)));
typedef short bf16x8 __attribute__((ext_vector_type(8)));
typedef GAS unsigned gu32;
typedef GAS unsigned long long gu64;
#define RLX_AGENT __ATOMIC_RELAXED, __HIP_MEMORY_SCOPE_AGENT
#define LDS_WAIT() asm volatile("s_waitcnt lgkmcnt(0)" ::: "memory")
#define VM_WAIT() asm volatile("s_waitcnt vmcnt(0)" ::: "memory")
__device__ __forceinline__ unsigned long long rt() { return __builtin_amdgcn_s_memrealtime(); }
__device__ __forceinline__ unsigned f2bf(float f) { unsigned u = __builtin_bit_cast(unsigned, f); return (u + 0x7fffu + ((u >> 16) & 1u)) >> 16; }
__device__ __forceinline__ unsigned pk2(float lo, float hi) { return f2bf(lo) | (f2bf(hi) << 16); }

#define XB_TMO      128
#define XB_XCNT(j)  (256  + 64 * (j))
#define XB_XSUB(j)  (1280 + 64 * (j))
#define XB_XGEN(j)  (2304 + 64 * (j))
#define XB_TOP      3328
#define XB_TOPGEN   3392
#define XCD_BAR_WORDS 3456
#define XB_SPIN_CAP (1u << 18)

__device__ __forceinline__ unsigned xb_ld(unsigned* p)              { return __hip_atomic_load(p, __ATOMIC_RELAXED, __HIP_MEMORY_SCOPE_AGENT); }
__device__ __forceinline__ unsigned xb_add(unsigned* p, unsigned v) { return __hip_atomic_fetch_add(p, v, __ATOMIC_RELAXED, __HIP_MEMORY_SCOPE_AGENT); }
__device__ __forceinline__ unsigned xb_xcc_id() { return (unsigned)__builtin_amdgcn_s_getreg((3 << 11) | 20) & 0xFu; }
#define XB_SPIN(cond, bar) do { unsigned _sp = 0; while (cond) { __builtin_amdgcn_s_sleep(1); \
    if ((++_sp & 255u) == 0u) { if (xb_ld(&(bar)[XB_TMO])) break; if (_sp > XB_SPIN_CAP) { atomicAdd(&(bar)[XB_TMO], 1u); break; } } } } while (0)

struct XcdBarrier {
    unsigned* bar; unsigned x;
    volatile LAS unsigned* st;
};

__device__ __forceinline__ XcdBarrier xcd_barrier_post(unsigned* bar, volatile LAS unsigned* st) {
    XcdBarrier b; b.bar = bar; b.x = xb_xcc_id(); b.st = st;
    if (threadIdx.x == 0) (void)xb_add(&bar[XB_XCNT(b.x)], 1u);
    return b;
}
__device__ __forceinline__ void xcd_barrier_complete(unsigned* bar, unsigned x, unsigned& nloc, unsigned& nx) {
    const unsigned G = gridDim.x * gridDim.y * gridDim.z;
    unsigned sum, cnt, mine, sp = 0u;
    for (;;) {
        sum = 0u; cnt = 0u; mine = 0u;
#pragma unroll
        for (unsigned j = 0; j < 16; ++j) { const unsigned c = xb_ld(&bar[XB_XCNT(j)]); sum += c; cnt += (c > 0u) ? 1u : 0u; mine = (j == x) ? c : mine; }
        if (sum == G) break;
        __builtin_amdgcn_s_sleep(1);
        if ((++sp & 255u) == 0u) { if (xb_ld(&bar[XB_TMO])) break; if (sp > XB_SPIN_CAP) { atomicAdd(&bar[XB_TMO], 1u); break; } }
    }
    nloc = mine > 0u ? mine : 1u; nx = cnt > 0u ? cnt : 1u;
}

__device__ __forceinline__ void xcd_barrier(const XcdBarrier& b) {
    asm volatile("s_waitcnt vmcnt(0)" ::: "memory");
    __syncthreads();
    if (threadIdx.x == 0) {
        unsigned* bar = b.bar;
        __builtin_amdgcn_s_waitcnt(0);
        unsigned nloc = b.st[0], nx = b.st[1];
        if (nloc == 0u) { xcd_barrier_complete(bar, b.x, nloc, nx); b.st[0] = nloc; b.st[1] = nx; }
        const unsigned old = xb_add(&bar[XB_XSUB(b.x)], 1u);
        const unsigned gen = old / nloc;
        if (old + 1u == (gen + 1u) * nloc) {
            __builtin_amdgcn_fence(__ATOMIC_RELEASE, "agent");
            asm volatile("s_waitcnt vmcnt(0)" ::: "memory");
            const unsigned og = xb_add(&bar[XB_TOP], 1u);
            const unsigned tg = og / nx;
            if (og + 1u == (tg + 1u) * nx) xb_add(&bar[XB_TOPGEN], 1u);
            else XB_SPIN(xb_ld(&bar[XB_TOPGEN]) == tg, bar);
            __builtin_amdgcn_fence(__ATOMIC_ACQUIRE, "agent");
            xb_add(&bar[XB_XGEN(b.x)], 1u);
            asm volatile("s_waitcnt vmcnt(0)" ::: "memory");
        } else {
            XB_SPIN(xb_ld(&bar[XB_XGEN(b.x)]) == gen, bar);
            __builtin_amdgcn_fence(__ATOMIC_ACQUIRE, "agent");
            asm volatile("s_waitcnt vmcnt(0)" ::: "memory");
        }
    }
    __syncthreads();
}

namespace att {
#define ATT_LAS __attribute__((address_space(3)))
typedef short bf16x8 __attribute__((ext_vector_type(8)));
typedef short s16x4 __attribute__((ext_vector_type(4)));
typedef short v4i16_t __attribute__((ext_vector_type(4)));
typedef float f32x16 __attribute__((ext_vector_type(16)));
typedef unsigned u32x4 __attribute__((ext_vector_type(4)));
typedef unsigned short bf16_t;
constexpr int SEQ = 8192, NT = SEQ / 64;
constexpr int KSLOT = 8192, VSLOT = 16384;
constexpr int L_K = 0, L_V = 2 * KSLOT, L_WS = L_V + 2 * VSLOT, L_BT = L_WS + 8 * 64 * 4, L_OST = L_BT + 2048, L_END = L_OST + 8 * 8192;
static_assert(L_END <= 131072, "attention LDS map");
__device__ __forceinline__ int crow(int r, int hi) { return (r & 3) + 8 * (r >> 2) + 4 * hi; }
__device__ __forceinline__ unsigned cvtpk(float lo, float hi) { typedef float f2 __attribute__((ext_vector_type(2))); typedef __bf16 b2 __attribute__((ext_vector_type(2))); f2 v = {lo, hi}; b2 b = __builtin_convertvector(v, b2); return __builtin_bit_cast(unsigned, b); }
__device__ __forceinline__ s16x4 vtr(const ATT_LAS unsigned char* p) { return __builtin_bit_cast(s16x4, __builtin_amdgcn_ds_read_tr16_b64_v4i16((ATT_LAS v4i16_t*)p)); }
__device__ __forceinline__ int t5_bucket(int rel) {
    const int n = rel < 0 ? -rel : rel; int b;
    if (n < 8) b = n; else if (n < 12) b = 8; else if (n < 16) b = 9; else if (n < 23) b = 10; else if (n < 32) b = 11;
    else if (n < 46) b = 12; else if (n < 64) b = 13; else if (n < 91) b = 14; else b = 15;
    return b + (rel > 0 ? 16 : 0);
}
#define ATT_WAIT_BAR() asm volatile("s_waitcnt vmcnt(0) lgkmcnt(0)\n\ts_barrier" ::: "memory")
#define ATT_MFMA(a, b, c) __builtin_amdgcn_mfma_f32_32x32x16_bf16((a), (b), (c), 0, 0, 0)

template <int THRL>
__device__ __forceinline__ void attn_unit(ATT_LAS unsigned char* lds, int b, int h, int qb, const bf16_t* Q, const bf16_t* K, const bf16_t* V, const float* rel_bias,
                                          float lam, const float* subln, float* stash, bf16_t* A2) {
    int tid_ = threadIdx.x; asm volatile("" : "+v"(tid_));
    const int tid = tid_, lane = tid & 63, r32 = lane & 31, hi = lane >> 5; const int wid = __builtin_amdgcn_readfirstlane(tid >> 6);
    const size_t rowbase = (size_t)b * SEQ; const int q0 = qb * 256 + wid * 32;
    ATT_LAS float* wsf = (ATT_LAS float*)(lds + L_WS) + wid * 64;
    ATT_LAS float* btab = (ATT_LAS float*)(lds + L_BT);
    __syncthreads();
    for (int i = tid; i < 257; i += 512) btab[i] = rel_bias[t5_bucket(i - 128) * 4 + h] * 1.4426950408889634f;
    __syncthreads();
    const float bl = btab[0], br = btab[256];
    const unsigned ldsw = (unsigned)wid * 1024u;
    const unsigned vpiece = (unsigned)(((wid >> 2) * 4 + (wid & 3)) * 1024);
    const int vrd = ((lane >> 4) & 1) * 32 + (lane & 3) * 8 + (4 * hi + ((lane & 15) >> 2)) * 64;
    const int krd = hi * 1024 + r32 * 16;
#pragma unroll 1
    for (int c = 0; c < 2; ++c) {
        const bf16_t* Qw = Q + (rowbase + q0) * 512 + h * 128 + c * 64;
        const bf16_t* ksrc = K + rowbase * 512 + h * 128 + c * 64 + (size_t)lane * 512 + wid * 8;
        const bf16_t* vsrc = V + rowbase * 512 + h * 128 + (size_t)(16 * (wid & 3) + (lane >> 2)) * 512 + (wid >> 2) * 32 + (lane & 3) * 8;
#define ATT_DMA(t, s) do { \
        __builtin_amdgcn_global_load_lds((const unsigned*)(ksrc + (size_t)(t) * 64 * 512), (ATT_LAS unsigned*)(lds + L_K + (s) * KSLOT + ldsw), 16, 0, 0); \
        __builtin_amdgcn_global_load_lds((const unsigned*)(vsrc + (size_t)(t) * 64 * 512), (ATT_LAS unsigned*)(lds + L_V + (s) * VSLOT + vpiece), 16, 0, 0); \
        __builtin_amdgcn_global_load_lds((const unsigned*)(vsrc + (size_t)(t) * 64 * 512 + 64), (ATT_LAS unsigned*)(lds + L_V + (s) * VSLOT + vpiece + 8192), 16, 0, 0); } while (0)
        __syncthreads();
        ATT_DMA(0, 0);
        bf16x8 qr[4];
#pragma unroll
        for (int d0 = 0; d0 < 4; ++d0) qr[d0] = *(const bf16x8*)(Qw + (size_t)r32 * 512 + d0 * 16 + hi * 8);
        f32x16 o[4];
#pragma unroll
        for (int d0 = 0; d0 < 4; ++d0)
#pragma unroll
            for (int r = 0; r < 16; ++r) o[d0][r] = 0.f;
        float mhat = 0.f, l_reg = 0.f; bool init_done = false;
#pragma unroll 1
        for (int t = 0; t < NT; ++t) {
            const int s = t & 1;
            ATT_WAIT_BAR();
            if (t + 1 < NT) ATT_DMA(t + 1, s ^ 1);
            const ATT_LAS unsigned char* kp = lds + L_K + s * KSLOT + krd;
            bf16x8 kf[8];
#pragma unroll
            for (int d0 = 0; d0 < 4; ++d0) { kf[2 * d0] = *(const ATT_LAS bf16x8*)(kp + d0 * 2048); kf[2 * d0 + 1] = *(const ATT_LAS bf16x8*)(kp + d0 * 2048 + 512); }
            f32x16 p0, p1;
            const int k0 = t * 64, rlo = k0 - (q0 + 31), rhi = k0 + 63 - q0;
            for (;;) {
                if (rhi <= -91 || rlo >= 91) { const float cv = (rhi <= -91 ? bl : br) - mhat;
#pragma unroll
                    for (int r = 0; r < 16; ++r) { p0[r] = cv; p1[r] = cv; } }
                else { const int dq = k0 + 4 * hi - (q0 + r32);
#pragma unroll
                    for (int r = 0; r < 16; ++r) { int d = dq + (r & 3) + 8 * (r >> 2); int d1 = d + 32;
                        d = d < -128 ? -128 : (d > 128 ? 128 : d); d1 = d1 < -128 ? -128 : (d1 > 128 ? 128 : d1);
                        p0[r] = btab[d + 128] - mhat; p1[r] = btab[d1 + 128] - mhat; } }
#pragma unroll
                for (int d0 = 0; d0 < 4; ++d0) { p0 = ATT_MFMA(kf[2 * d0], qr[d0], p0); p1 = ATT_MFMA(kf[2 * d0 + 1], qr[d0], p1); }
                float rm;
                { float a = fmaxf(fmaxf(p0[0], p0[1]), p1[0]), bq = fmaxf(fmaxf(p0[2], p0[3]), p1[1]); a = fmaxf(fmaxf(a, p1[2]), p1[3]);
#pragma unroll
                  for (int r = 4; r < 16; r += 4) { a = fmaxf(fmaxf(a, p0[r]), p0[r + 1]); bq = fmaxf(fmaxf(bq, p0[r + 2]), p0[r + 3]); a = fmaxf(fmaxf(a, p1[r]), p1[r + 1]); bq = fmaxf(fmaxf(bq, p1[r + 2]), p1[r + 3]); }
                  rm = fmaxf(a, bq); auto rr = __builtin_amdgcn_permlane32_swap(__float_as_uint(rm), __float_as_uint(rm), false, false); rm = fmaxf(__uint_as_float(rr[0]), __uint_as_float(rr[1])); }
                if (!init_done) { mhat = rm; init_done = true; continue; }
                if (!__any(rm > (float)THRL)) break;
                const float dl = fmaxf(rm, 0.f); mhat += dl;
                const float f = __builtin_amdgcn_exp2f(-dl); l_reg *= f; if (hi == 0) wsf[r32] = f;
                asm volatile("s_waitcnt lgkmcnt(0)" ::: "memory");
                float frs[16];
#pragma unroll
                for (int r = 0; r < 16; ++r) frs[r] = wsf[crow(r, hi)];
#pragma unroll
                for (int d0 = 0; d0 < 4; ++d0)
#pragma unroll
                    for (int r = 0; r < 16; ++r) o[d0][r] *= frs[r];
                asm volatile("s_waitcnt lgkmcnt(0)" ::: "memory");
            }
            float sacc = 0.f;
#pragma unroll
            for (int r = 0; r < 16; ++r) { p0[r] = __builtin_amdgcn_exp2f(p0[r]); p1[r] = __builtin_amdgcn_exp2f(p1[r]); sacc += p0[r] + p1[r]; }
            l_reg += sacc;
            u32x4 pw[4];
#pragma unroll
            for (int j = 0; j < 4; ++j) { pw[0][j] = cvtpk(p0[2 * j], p0[2 * j + 1]); pw[1][j] = cvtpk(p0[8 + 2 * j], p0[9 + 2 * j]); pw[2][j] = cvtpk(p1[2 * j], p1[2 * j + 1]); pw[3][j] = cvtpk(p1[8 + 2 * j], p1[9 + 2 * j]); }
            __builtin_amdgcn_sched_barrier(0);
            const ATT_LAS unsigned char* vp = lds + L_V + s * VSLOT + vrd;
#pragma unroll
            for (int d0 = 0; d0 < 4; ++d0) {
                s16x4 vl[4], vh[4];
#pragma unroll
                for (int ks = 0; ks < 4; ++ks) { vl[ks] = vtr(vp + d0 * 4096 + ks * 1024); vh[ks] = vtr(vp + d0 * 4096 + ks * 1024 + 512); }
#pragma unroll
                for (int ks = 0; ks < 4; ++ks) { const bf16x8 vf = (bf16x8){vl[ks][0], vl[ks][1], vl[ks][2], vl[ks][3], vh[ks][0], vh[ks][1], vh[ks][2], vh[ks][3]};
                    o[d0] = ATT_MFMA(__builtin_bit_cast(bf16x8, pw[ks]), vf, o[d0]); }
                __builtin_amdgcn_sched_barrier(0);
            }
        }
        { auto rr = __builtin_amdgcn_permlane32_swap(__float_as_uint(l_reg), __float_as_uint(l_reg), false, false); l_reg = __uint_as_float(rr[0]) + __uint_as_float(rr[1]); }
        if (hi == 0) wsf[32 + r32] = l_reg;
        asm volatile("s_waitcnt lgkmcnt(0)" ::: "memory");
        float rli[16];
#pragma unroll
        for (int r = 0; r < 16; ++r) rli[r] = __builtin_amdgcn_rcpf(wsf[32 + crow(r, hi)]);
        asm volatile("s_waitcnt lgkmcnt(0)" ::: "memory");
        size_t sbase = (rowbase + q0 + 4 * hi) * 512 + h * 128 + r32; asm volatile("" : "+v"(sbase));
        float* st = stash + sbase;
        if (c == 0) {
#pragma unroll
            for (int r = 0; r < 16; ++r)
#pragma unroll
                for (int d0 = 0; d0 < 4; ++d0) st[(size_t)((r & 3) + 8 * (r >> 2)) * 512 + d0 * 32] = o[d0][r] * rli[r];
        } else {
#ifndef NO_EPI1
            float ss[16];
#pragma unroll
            for (int r = 0; r < 16; ++r) { float sq = 0.f;
#pragma unroll
                for (int d0 = 0; d0 < 4; ++d0) { const float dv = st[(size_t)((r & 3) + 8 * (r >> 2)) * 512 + d0 * 32] - lam * (o[d0][r] * rli[r]); o[d0][r] = dv; sq += dv * dv; }
                ss[r] = sq; if ((r & 3) == 3) asm volatile("" ::: "memory"); }
#pragma unroll
            for (int off = 1; off < 32; off <<= 1)
#pragma unroll
                for (int r = 0; r < 16; ++r) ss[r] += __shfl_xor(ss[r], off);
            float g4[4];
#pragma unroll
            for (int d0 = 0; d0 < 4; ++d0) g4[d0] = subln[d0 * 32 + r32] * 0.8f;
            ATT_LAS bf16_t* stg = (ATT_LAS bf16_t*)(lds + L_OST) + wid * 4096;
#pragma unroll
            for (int r = 0; r < 16; ++r) { const float rs = __builtin_amdgcn_rsqf(ss[r] * (1.0f / 128.0f) + 1e-6f);
#pragma unroll
                for (int d0 = 0; d0 < 4; ++d0) { const float v = o[d0][r] * rs * g4[d0]; const unsigned u = __float_as_uint(v); stg[crow(r, hi) * 128 + d0 * 32 + r32] = (bf16_t)((u + 0x7fffu + ((u >> 16) & 1u)) >> 16); } }
            asm volatile("s_waitcnt lgkmcnt(0)" ::: "memory");
            size_t obase = (rowbase + q0 + (lane >> 4)) * 1024 + h * 128 + (lane & 15) * 8; asm volatile("" : "+v"(obase));
            bf16_t* Ow = A2 + obase;
#pragma unroll
            for (int i = 0; i < 8; ++i) { const int row = i * 4 + (lane >> 4), ch = lane & 15; const u32x4 v = *(const ATT_LAS u32x4*)(stg + row * 128 + ch * 8); *(u32x4*)(Ow + (size_t)(i * 4) * 1024) = v; }
            asm volatile("s_waitcnt lgkmcnt(0)" ::: "memory");
#endif
        }
#undef ATT_DMA
    }
}
}

namespace hyc {
#define HYC_LAS __attribute__((address_space(3)))
#define HYC_GAS __attribute__((address_space(1)))
typedef short bf16x8 __attribute__((ext_vector_type(8)));
typedef bf16x8 ubf16x8 __attribute__((aligned(2)));
typedef float f32x16 __attribute__((ext_vector_type(16)));
typedef unsigned u32x4 __attribute__((ext_vector_type(4)));
typedef u32x4 u32x4a4 __attribute__((aligned(4)));
typedef unsigned short bf16_t;
constexpr int SEQ = 8192, M = 16384;
constexpr int UBLK = 144, UBOFF = 160 * UBLK;
constexpr int L_U = 0, L_T0 = 49152, L_T1 = 81920, L_F0 = 49152, L_F1 = L_F0 + 32768 + 68, L_END = L_F1 + 32768;
static_assert(2 * UBOFF <= L_T0 && (UBOFF % 256) == 0 && L_END <= 131072, "conv LDS map");
__device__ __forceinline__ float bf2f(bf16_t b) { return __builtin_bit_cast(float, (unsigned)b << 16); }
__device__ __forceinline__ unsigned f2bf(float f) { unsigned u = __builtin_bit_cast(unsigned, f); return (u + 0x7fffu + ((u >> 16) & 1u)) >> 16; }
__device__ __forceinline__ int crow(int r, int hi) { return (r & 3) + 8 * (r >> 2) + 4 * hi; }

__device__ __forceinline__ void sconv8(const HYC_LAS bf16_t* T, int m0, float w0, float w1, float w2, float bb, float (&u)[8]) {
    const u32x4 v = *(const HYC_LAS u32x4*)(T + m0);
    float z[10]; const int t = m0 & (SEQ - 1);
    z[0] = t > 0 ? bf2f(T[m0 - 1]) : 0.f; z[9] = t + 8 < SEQ ? bf2f(T[m0 + 8]) : 0.f;
#pragma unroll
    for (int j = 0; j < 4; ++j) { z[1 + 2 * j] = __builtin_bit_cast(float, v[j] << 16); z[2 + 2 * j] = __builtin_bit_cast(float, v[j] & 0xffff0000u); }
#pragma unroll
    for (int j = 0; j < 8; ++j) u[j] = bb + w0 * z[j] + w1 * z[j + 1] + w2 * z[j + 2];
}

__device__ __forceinline__ void conv_channel(HYC_LAS unsigned char* lds, int c, const bf16_t* ZT, const bf16_t* GR, const float* cw, const float* cb, float hb, bf16_t* YT) {
    int tid_ = threadIdx.x; asm volatile("" : "+v"(tid_));
    const int tid = tid_, lane = tid & 63, r32 = lane & 31, hi = lane >> 5; const int wid = __builtin_amdgcn_readfirstlane(tid >> 6);
    HYC_LAS bf16_t* T0 = (HYC_LAS bf16_t*)(lds + L_T0); HYC_LAS bf16_t* T1 = (HYC_LAS bf16_t*)(lds + L_T1);
    const bf16_t* z0row = ZT + (size_t)c * M;
    __syncthreads();
    for (int i = tid; i < M / 8; i += 512) ((HYC_LAS u32x4*)T0)[i] = ((const HYC_GAS u32x4*)z0row)[i];
    __syncthreads();
    { const float w0 = cw[c], w1 = cw[1536 + c], w2 = cw[3072 + c], bb = cb[c];
      for (int i = tid; i < M / 8; i += 512) { float u[8]; sconv8(T0, i * 8, w0, w1, w2, bb, u);
          u32x4 o; o.x = f2bf(u[0]) | (f2bf(u[1]) << 16); o.y = f2bf(u[2]) | (f2bf(u[3]) << 16); o.z = f2bf(u[4]) | (f2bf(u[5]) << 16); o.w = f2bf(u[6]) | (f2bf(u[7]) << 16);
          ((HYC_GAS u32x4*)(YT + (size_t)c * M))[i] = o; } }
    __syncthreads();
    for (int i = tid; i < M / 8; i += 512) { ((HYC_LAS u32x4*)T0)[i] = ((const HYC_GAS u32x4*)(ZT + (size_t)(512 + c) * M))[i]; ((HYC_LAS u32x4*)T1)[i] = ((const HYC_GAS u32x4*)(ZT + (size_t)(1024 + c) * M))[i]; }
    for (int i = tid; i < 2 * 2 * 16 * (UBLK / 16); i += 512) { const int b = i / (2 * 16 * 9), rem = i % (2 * 16 * 9), side = rem / (16 * 9), q = rem % (16 * 9);
        *(HYC_LAS u32x4*)(lds + L_U + b * UBOFF + side * (144 * UBLK) + q * 16) = (u32x4){0u, 0u, 0u, 0u}; }
    __syncthreads();
    { const float a0 = cw[512 + c], a1 = cw[1536 + 512 + c], a2 = cw[3072 + 512 + c], ab = cb[512 + c];
      const float v0 = cw[1024 + c], v1 = cw[1536 + 1024 + c], v2 = cw[3072 + 1024 + c], vb = cb[1024 + c];
      for (int i = tid; i < M / 8; i += 512) { float ux[8], uv[8]; sconv8(T0, i * 8, a0, a1, a2, ab, ux); sconv8(T1, i * 8, v0, v1, v2, vb, uv);
          u32x4 o; o.x = f2bf(ux[0] * uv[0]) | (f2bf(ux[1] * uv[1]) << 16); o.y = f2bf(ux[2] * uv[2]) | (f2bf(ux[3] * uv[3]) << 16);
          o.z = f2bf(ux[4] * uv[4]) | (f2bf(ux[5] * uv[5]) << 16); o.w = f2bf(ux[6] * uv[6]) | (f2bf(ux[7] * uv[7]) << 16);
          const int m0 = i * 8, b = m0 >> 13, t = m0 & (SEQ - 1);
          *(HYC_LAS u32x4*)(lds + L_U + b * UBOFF + ((t >> 6) + 16) * UBLK + (t & 63) * 2) = o; } }
    __syncthreads();
    { const bf16_t* grow = GR + (size_t)c * 16384;
      for (int i = tid; i < 16384 / 8; i += 512) { const u32x4 v = ((const HYC_GAS u32x4*)grow)[i]; const unsigned nx = ((const HYC_GAS unsigned*)grow)[4 * i + 4 < 8192 ? 4 * i + 4 : 8191];
          ((HYC_LAS u32x4*)(lds + L_F0))[i] = v;
          HYC_LAS unsigned* f1 = (HYC_LAS unsigned*)(lds + L_F1) + 4 * i;
          f1[0] = (v.x >> 16) | (v.y << 16); f1[1] = (v.y >> 16) | (v.z << 16); f1[2] = (v.z >> 16) | (v.w << 16); f1[3] = (v.w >> 16) | (nx << 16); } }
    __syncthreads();
    const int i0 = 16 * wid, dlo = i0 - 127;
    const int il = r32 & 15, bb_ = r32 >> 4;
    int aoff = L_U + bb_ * UBOFF + (i0 + il - dlo + 16) * UBLK + hi * 16;
    int goff = ((r32 & 1) ? (L_F1 - 2) : L_F0) + 2 * (8192 - (64 * dlo + r32 - 8 * hi));
#define HYC_LDF(off) __builtin_bit_cast(bf16x8, *(const HYC_LAS u32x4a4*)(lds + (off)))
    bf16x8 f0 = HYC_LDF(goff - 64), f1 = HYC_LDF(goff - 32), f2 = HYC_LDF(goff), f3 = HYC_LDF(goff + 32), f4 = HYC_LDF(goff + 64), f5 = HYC_LDF(goff + 96);
    f32x16 acc0, acc1;
#pragma unroll
    for (int r = 0; r < 16; ++r) { acc0[r] = 0.f; acc1[r] = 0.f; }
#pragma unroll 1
    for (int e = 0; e < 143; ++e) {
        const int gn = goff - (e < 142 ? 128 : 0);
        const bf16x8 n0 = HYC_LDF(gn - 64), n1 = HYC_LDF(gn - 32), n2 = HYC_LDF(gn), n3 = HYC_LDF(gn + 32);
        const bf16x8 a0 = *(const HYC_LAS bf16x8*)(lds + aoff), a1 = *(const HYC_LAS bf16x8*)(lds + aoff + 32), a2 = *(const HYC_LAS bf16x8*)(lds + aoff + 64), a3 = *(const HYC_LAS bf16x8*)(lds + aoff + 96);
        acc0 = __builtin_amdgcn_mfma_f32_32x32x16_bf16(a0, f2, acc0, 0, 0, 0); acc1 = __builtin_amdgcn_mfma_f32_32x32x16_bf16(a0, f0, acc1, 0, 0, 0);
        acc0 = __builtin_amdgcn_mfma_f32_32x32x16_bf16(a1, f3, acc0, 0, 0, 0); acc1 = __builtin_amdgcn_mfma_f32_32x32x16_bf16(a1, f1, acc1, 0, 0, 0);
        acc0 = __builtin_amdgcn_mfma_f32_32x32x16_bf16(a2, f4, acc0, 0, 0, 0); acc1 = __builtin_amdgcn_mfma_f32_32x32x16_bf16(a2, f2, acc1, 0, 0, 0);
        acc0 = __builtin_amdgcn_mfma_f32_32x32x16_bf16(a3, f5, acc0, 0, 0, 0); acc1 = __builtin_amdgcn_mfma_f32_32x32x16_bf16(a3, f3, acc1, 0, 0, 0);
        f4 = f0; f5 = f1; f0 = n0; f1 = n1; f2 = n2; f3 = n3; goff = gn; aoff -= UBLK;
    }
#undef HYC_LDF
    bf16_t* yrow = YT + (size_t)c * M;
#pragma unroll
    for (int nt = 0; nt < 2; ++nt)
#pragma unroll
        for (int r = 0; r < 16; ++r) { const int rho = crow(r, hi), i = i0 + (rho & 15), b = rho >> 4, t = 64 * i + 32 * nt + r32, m = b * SEQ + t;
            const float vx = bf2f(*(const HYC_LAS bf16_t*)(lds + L_U + b * UBOFF + (i + 16) * UBLK + (32 * nt + r32) * 2));
            const float x0 = bf2f(yrow[m]);
            const float a = nt == 0 ? acc0[r] : acc1[r];
            yrow[m] = (bf16_t)f2bf((a + vx * hb) * x0); }
}
}

constexpr int NWAVES = 8;
constexpr int BATCH = 2, SEQ = 8192, D = 1024, M = BATCH * SEQ, FF = 2816, DIN = 3072, NH = 4;
constexpr float EPS = 1e-6f;
constexpr float LOG2E = 1.4426950408889634f;
constexpr float C2 = 0.125f * LOG2E;

constexpr size_t MiB = 1u << 20;
constexpr size_t WS_CTL = 0, CTL_ZERO_BYTES = 64 * 1024;
constexpr size_t WS_WGU1 = 1 * MiB;
constexpr size_t WS_WD1 = 12 * MiB;
constexpr size_t WS_WIN = 18 * MiB;
constexpr size_t WS_WOUT = 24 * MiB;
constexpr size_t WS_WGU2 = 26 * MiB;
constexpr size_t WS_WD2 = 37 * MiB;
constexpr size_t WS_SSQ = 43 * MiB;
constexpr size_t WS_G = 46 * MiB;
constexpr size_t WS_XB = 62 * MiB;
constexpr size_t WS_X1 = 94 * MiB;
constexpr size_t WS_H = 158 * MiB;
constexpr size_t WS_Q = WS_H, WS_K = WS_H + 16 * MiB, WS_V = WS_H + 32 * MiB;
constexpr size_t WS_A2 = WS_H + 48 * MiB;
constexpr size_t WS_END = 246 * MiB;
constexpr size_t DO_ZT = 0, DO_YT = 48 * MiB;
constexpr int CW_TMO = 0, CW_BAR = 4096;

constexpr int RING_OFF = 0, RING_BYTES = 131072;
constexpr int LDSCTL_OFF = RING_BYTES, MISC_OFF = LDSCTL_OFF + 320;
constexpr int LDS_BYTES = 147456;

struct Frame {
    LAS unsigned char* lds;
    volatile LAS unsigned* MISC;
    gu32* ctl;
    int tid, lane, wave;
    int vcu, G;
};

__device__ __forceinline__ float bf2f(bf16 b) { return __builtin_bit_cast(float, (unsigned)b << 16); }
__device__ __forceinline__ float wave_sum(float v) {
#pragma unroll
    for (int o = 1; o < 64; o <<= 1) v += __shfl_xor(v, o);
    return v;
}

__device__ __forceinline__ void p0_transpose_item(const float* W, const float* gain, int K, int N, bf16* WT, int item, int mode, int up, LAS float* scr, int lane) {
    const int nblk = N / 32, kb = item / nblk, nb = item % nblk, k0 = 64 * kb, n0 = 32 * nb;
    const int dst_row0 = mode ? (256 * (n0 / 128) + (n0 % 128) + 128 * up) : n0;
    const int q = lane >> 3, c4 = (lane & 7) * 4;
    f32x4 v[8]; float g[8];
#pragma unroll
    for (int j = 0; j < 8; ++j) { v[j] = *(const GAS f32x4*)(W + (size_t)(k0 + 8 * j + q) * N + n0 + c4); g[j] = gain ? gain[k0 + 8 * j + q] : 1.0f; }
#pragma unroll
    for (int j = 0; j < 8; ++j) { LAS float* d = scr + (8 * j + q) * 33 + c4; d[0] = v[j].x * g[j]; d[1] = v[j].y * g[j]; d[2] = v[j].z * g[j]; d[3] = v[j].w * g[j]; }
    LDS_WAIT(); asm volatile("" ::: "memory");
    const int c = lane & 7;
#pragma unroll
    for (int j = 0; j < 4; ++j) { const int n = (lane >> 3) + 8 * j; const LAS float* s = scr + (8 * c) * 33 + n;
        v4u o; o.x = pk2(s[0 * 33], s[1 * 33]); o.y = pk2(s[2 * 33], s[3 * 33]); o.z = pk2(s[4 * 33], s[5 * 33]); o.w = pk2(s[6 * 33], s[7 * 33]);
        *(GAS v4u*)(WT + (size_t)(dst_row0 + n) * K + k0 + 8 * c) = o; }
    LDS_WAIT(); asm volatile("" ::: "memory");
}
__device__ __forceinline__ void row_to_bf16_ssq2(const float* x0, const float* x1, bf16* o0, bf16* o1, float* s0, float* s1, int lane) {
    f32x4 a[4], b[4];
#pragma unroll
    for (int p = 0; p < 4; ++p) { a[p] = *(const GAS f32x4*)(x0 + p * 256 + lane * 4); b[p] = *(const GAS f32x4*)(x1 + p * 256 + lane * 4); }
#pragma unroll
    for (int p = 0; p < 4; ++p) { const float sa = wave_sum((a[p].x * a[p].x + a[p].y * a[p].y) + (a[p].z * a[p].z + a[p].w * a[p].w)), sb = wave_sum((b[p].x * b[p].x + b[p].y * b[p].y) + (b[p].z * b[p].z + b[p].w * b[p].w));
        if (lane == 0) { s0[p] = sa; s1[p] = sb; }
        *(GAS unsigned long long*)(o0 + p * 256 + lane * 4) = (unsigned long long)pk2(a[p].x, a[p].y) | ((unsigned long long)pk2(a[p].z, a[p].w) << 32);
        *(GAS unsigned long long*)(o1 + p * 256 + lane * 4) = (unsigned long long)pk2(b[p].x, b[p].y) | ((unsigned long long)pk2(b[p].z, b[p].w) << 32); }
}
__device__ __forceinline__ void p0_filters_unit(Frame& F, const float* const* in, bf16* G, int u) {
    LAS float* a3s = (LAS float*)(F.lds + RING_OFF);
    const float *w1 = in[15], *b1 = in[16], *w2 = in[17], *b2 = in[18], *w3 = in[19], *b3 = in[20], *w4 = in[21], *freq = in[22];
    const int lane = F.lane; const float fr = freq[lane];
    { float aq[4];
#pragma unroll
      for (int q = 0; q < 4; ++q) { const int i = 32 * u + F.wave * 4 + q; float z = 0.f;
          const float w = (6.283185307179586f * (float)i) / (float)SEQ; const int j = (lane - 1) & 15; const float f = 1e-4f + (float)j * ((15.0f - 1e-4f) / 15.0f); const float fw = f * w;
          if (lane == 0) z = (float)i / (float)(SEQ - 1); else if (lane <= 16) z = cosf(fw); else if (lane <= 32) z = -sinf(fw);
          aq[q] = z; }
      { float r[33]; const float c1 = b1[lane];
#pragma unroll
        for (int ch = 0; ch < 3; ++ch) { const float* wc = w1 + ch * 1024 + lane; asm volatile("" : "+v"(wc));
#pragma unroll
            for (int e = 0; e < 16; ++e) if (ch * 16 + e < 33) r[ch * 16 + e] = wc[e * 64]; }
#pragma unroll
        for (int q = 0; q < 4; ++q) { float s = c1;
#pragma unroll
            for (int e = 0; e < 33; ++e) s += __shfl(aq[q], e) * r[e];
            aq[q] = sinf(fr * s); } }
      asm volatile("" ::: "memory");
#pragma unroll 1
      for (int layer = 0; layer < 2; ++layer) { const float* wl = layer ? w3 : w2; const float cb_ = (layer ? b3 : b2)[lane]; float r[64];
#pragma unroll
        for (int ch = 0; ch < 4; ++ch) { const float* wc = wl + ch * 1024 + lane; asm volatile("" : "+v"(wc));
#pragma unroll
            for (int e = 0; e < 16; ++e) r[ch * 16 + e] = wc[e * 64]; }
#pragma unroll
        for (int q = 0; q < 4; ++q) { float s = cb_;
#pragma unroll
            for (int e = 0; e < 64; ++e) s += __shfl(aq[q], e) * r[e];
            aq[q] = sinf(fr * s); }
        asm volatile("" ::: "memory"); }
#pragma unroll
      for (int q = 0; q < 4; ++q) a3s[(F.wave * 4 + q) * 64 + lane] = aq[q]; }
    __syncthreads();
    { const int c = F.tid;
      const float mind = logf(1e-2f) / 1.5f, maxd = logf(1e-2f) / 0.3f; const float ad = fabsf(mind + (float)c * ((maxd - mind) / 511.0f));
      bf16* gc = G + (size_t)c * 16384 + 8192;
      float acc0[32], acc1[32];
#pragma unroll
      for (int p = 0; p < 32; ++p) { acc0[p] = 0.f; acc1[p] = 0.f; }
      { float wa[4], wb[4], na[4], nb[4]; const float* wp = w4 + c;
#pragma unroll
        for (int kk = 0; kk < 4; ++kk) { wa[kk] = wp[kk * 1024]; wb[kk] = wp[kk * 1024 + 512]; }
#pragma unroll 1
        for (int k = 0; k < 64; k += 4) {
            const float* wn = wp + (k + 4 < 64 ? (k + 4) * 1024 : 0);
#pragma unroll
            for (int kk = 0; kk < 4; ++kk) { na[kk] = wn[kk * 1024]; nb[kk] = wn[kk * 1024 + 512]; }
#pragma unroll
            for (int p = 0; p < 32; ++p) { const f32x4 a = *(const LAS f32x4*)(a3s + p * 64 + k);
                acc0[p] += a.x * wa[0]; acc1[p] += a.x * wb[0]; acc0[p] += a.y * wa[1]; acc1[p] += a.y * wb[1]; acc0[p] += a.z * wa[2]; acc1[p] += a.z * wb[2]; acc0[p] += a.w * wa[3]; acc1[p] += a.w * wb[3]; }
#pragma unroll
            for (int kk = 0; kk < 4; ++kk) { wa[kk] = na[kk]; wb[kk] = nb[kk]; } } }
      const int i0 = 32 * u;
#pragma unroll
      for (int p8 = 0; p8 < 4; ++p8) { unsigned w[4];
#pragma unroll
          for (int h = 0; h < 4; ++h) { const int p = p8 * 8 + 2 * h; const float d0 = expf(-((float)(i0 + p) / (float)(SEQ - 1)) * ad), d1 = expf(-((float)(i0 + p + 1) / (float)(SEQ - 1)) * ad);
              const float e0 = (i0 + p == 0) ? acc0[p] : acc1[p];
              w[h] = pk2(e0 * d0, acc1[p + 1] * d1); }
          *(GAS v4u*)(gc + i0 + p8 * 8) = (v4u){w[0], w[1], w[2], w[3]}; }
#pragma unroll
      for (int p = 0; p < 32; ++p) { const int i = i0 + p; const float dd = expf(-((float)i / (float)(SEQ - 1)) * ad);
          if (i >= 1) gc[-i] = (bf16)f2bf(acc0[p] * dd); else gc[-8192] = 0; }
    }
    __syncthreads();
}

constexpr int I_GU = (D / 64) * (FF / 32), I_DN = (FF / 64) * (D / 32), I_IN = (D / 64) * (DIN / 32), I_OUT = (D / 64) * (D / 32);
constexpr int NITEMS = 4 * I_GU + 2 * I_DN + I_IN + I_OUT;
__device__ __forceinline__ void p0_transpose_range(Frame& F, const float* const* in, unsigned char* ws, int first, int last, int gw, int NGW) {
    LAS float* scr = (LAS float*)(F.lds + RING_OFF + F.wave * 16384);
    bf16 *Wgu1 = (bf16*)(ws + WS_WGU1), *Wd1 = (bf16*)(ws + WS_WD1), *Win = (bf16*)(ws + WS_WIN), *Wout = (bf16*)(ws + WS_WOUT), *Wgu2 = (bf16*)(ws + WS_WGU2), *Wd2 = (bf16*)(ws + WS_WD2);
    for (int it = first + gw; it < last; it += NGW) {
        int r = it;
        if (r < I_GU) { p0_transpose_item(in[3], in[2], D, FF, Wgu1, r, 1, 0, scr, F.lane); continue; } r -= I_GU;
        if (r < I_GU) { p0_transpose_item(in[4], in[2], D, FF, Wgu1, r, 1, 1, scr, F.lane); continue; } r -= I_GU;
        if (r < I_DN) { p0_transpose_item(in[5], nullptr, FF, D, Wd1, r, 0, 0, scr, F.lane); continue; } r -= I_DN;
        if (r < I_IN) { p0_transpose_item(in[7], in[6], D, DIN, Win, r, 0, 0, scr, F.lane); continue; } r -= I_IN;
        if (r < I_OUT) { p0_transpose_item(in[25], nullptr, D, D, Wout, r, 0, 0, scr, F.lane); continue; } r -= I_OUT;
        if (r < I_GU) { p0_transpose_item(in[27], in[26], D, FF, Wgu2, r, 1, 0, scr, F.lane); continue; } r -= I_GU;
        if (r < I_GU) { p0_transpose_item(in[28], in[26], D, FF, Wgu2, r, 1, 1, scr, F.lane); continue; } r -= I_GU;
        p0_transpose_item(in[29], nullptr, FF, D, Wd2, r, 0, 0, scr, F.lane);
    }
}
__device__ __forceinline__ void p0_early(Frame& F, const float* const* in, unsigned char* ws) {
    const int gw = F.vcu * NWAVES + F.wave, NGW = F.G * NWAVES;
    p0_transpose_range(F, in, ws, 0, 2 * I_GU, gw, NGW);
    bf16* XB = (bf16*)(ws + WS_XB); float* ssq = (float*)(ws + WS_SSQ);
    for (int m = 2 * gw; m < M; m += 2 * NGW) row_to_bf16_ssq2(in[0] + (size_t)m * D, in[0] + (size_t)(m + 1) * D, XB + (size_t)m * D, XB + (size_t)(m + 1) * D, ssq + (size_t)m * 4, ssq + (size_t)(m + 1) * 4, F.lane);
}
__device__ __forceinline__ void p0_late(Frame& F, const float* const* in, unsigned char* ws, int rank, int nranks) {
    __syncthreads();
    p0_transpose_range(F, in, ws, 2 * I_GU, NITEMS, rank * NWAVES + F.wave, nranks * NWAVES);
    __syncthreads();
}

__device__ __forceinline__ int t5_bucket(int rel) {
    const int n = rel < 0 ? -rel : rel; int b;
    if (n < 8) b = n; else if (n < 12) b = 8; else if (n < 16) b = 9; else if (n < 23) b = 10; else if (n < 32) b = 11;
    else if (n < 46) b = 12; else if (n < 64) b = 13; else if (n < 91) b = 14; else b = 15;
    return b + (rel > 0 ? 16 : 0);
}

__device__ __forceinline__ void attn_simple_pair(Frame& F, int vb, const bf16* Q, const bf16* K, const bf16* V, const float* const* in, bf16* A2) {
    const int half = F.tid >> 8, tid = F.tid & 255, part = tid & 7, ql = tid >> 3;
    LAS float* Ks = (LAS float*)(F.lds + RING_OFF + half * 20480);
    LAS float* Vs = Ks + 16 * 128;
    LAS float* btab = Vs + 16 * 128;
    LAS float* lam_s = btab + 260;
    const int qblk = vb & 255, h = (vb >> 8) & 3, b = vb >> 10;
    const int qpos = qblk * 32 + ql; const size_t mrow = (size_t)b * SEQ + qpos;
    const float* rel_bias = in[1];
    __syncthreads();
    for (int i = tid; i < 257; i += 256) btab[i] = rel_bias[t5_bucket(i - 128) * NH + h] * LOG2E;
    if (tid == 0) { float s1 = 0.f, s2 = 0.f; for (int i = 0; i < 64; ++i) { s1 += in[8][i] * in[9][i]; s2 += in[10][i] * in[11][i]; } lam_s[0] = expf(s1) - expf(s2) + 0.2f; }
    float q1[8], q2[8];
#pragma unroll
    for (int d = 0; d < 8; ++d) { q1[d] = bf2f(Q[mrow * 512 + h * 128 + part * 8 + d]); q2[d] = bf2f(Q[mrow * 512 + h * 128 + 64 + part * 8 + d]); }
    float o1[16], o2[16];
#pragma unroll
    for (int e = 0; e < 16; ++e) { o1[e] = 0.f; o2[e] = 0.f; }
    float m1 = -1e30f, m2 = -1e30f, l1 = 0.f, l2 = 0.f;
    for (int k0 = 0; k0 < SEQ; k0 += 8) {
        __syncthreads();
        for (int i = tid; i < 8 * 128; i += 256) { const int kk = i >> 7, c = i & 127; const size_t kr = (size_t)b * SEQ + k0 + kk;
            Ks[kk * 128 + c] = bf2f(K[kr * 512 + h * 128 + c]); Vs[kk * 128 + c] = bf2f(V[kr * 512 + h * 128 + c]); }
        __syncthreads();
        float s1[8], s2[8]; float t1 = -1e30f, t2 = -1e30f;
#pragma unroll
        for (int j = 0; j < 8; ++j) { float a = 0.f, c = 0.f;
#pragma unroll
            for (int d = 0; d < 8; ++d) { a += q1[d] * Ks[j * 128 + part * 8 + d]; c += q2[d] * Ks[j * 128 + 64 + part * 8 + d]; }
            a += __shfl_xor(a, 1); a += __shfl_xor(a, 2); a += __shfl_xor(a, 4); c += __shfl_xor(c, 1); c += __shfl_xor(c, 2); c += __shfl_xor(c, 4);
            int rel = k0 + j - qpos; rel = rel < -128 ? -128 : (rel > 128 ? 128 : rel); const float bb = btab[rel + 128];
            a += bb; c += bb; s1[j] = a; s2[j] = c; t1 = fmaxf(t1, a); t2 = fmaxf(t2, c); }
        const float n1 = fmaxf(m1, t1), n2 = fmaxf(m2, t2); const float a1 = exp2f(m1 - n1), a2 = exp2f(m2 - n2);
        m1 = n1; m2 = n2; l1 *= a1; l2 *= a2;
#pragma unroll
        for (int e = 0; e < 16; ++e) { o1[e] *= a1; o2[e] *= a2; }
#pragma unroll
        for (int j = 0; j < 8; ++j) { const float p1 = exp2f(s1[j] - m1), p2 = exp2f(s2[j] - m2); l1 += p1; l2 += p2;
#pragma unroll
            for (int e = 0; e < 16; ++e) { const float v = Vs[j * 128 + part * 16 + e]; o1[e] += p1 * v; o2[e] += p2 * v; } }
    }
    const float lam = lam_s[0]; const float i1 = 1.f / l1, i2 = lam / l2; float ss = 0.f;
#pragma unroll
    for (int e = 0; e < 16; ++e) { o1[e] = o1[e] * i1 - o2[e] * i2; ss += o1[e] * o1[e]; }
    ss += __shfl_xor(ss, 1); ss += __shfl_xor(ss, 2); ss += __shfl_xor(ss, 4);
    const float rs = rsqrtf(ss * (1.f / 128.f) + EPS) * 0.8f; const float* subln = in[12];
#pragma unroll
    for (int e = 0; e < 16; ++e) A2[mrow * D + h * 128 + part * 16 + e] = (bf16)f2bf(o1[e] * rs * subln[part * 16 + e]);
}

__device__ __forceinline__ void hyena_simple_channel(Frame& F, int c, const bf16* ZT, const bf16* G, const float* const* in, bf16* YT) {
    LAS bf16* X0 = (LAS bf16*)(F.lds + RING_OFF);
    LAS bf16* U = (LAS bf16*)(F.lds + RING_OFF + 32768);
    LAS bf16* T0 = (LAS bf16*)(F.lds + RING_OFF + 65536);
    LAS bf16* T1 = (LAS bf16*)(F.lds + RING_OFF + 98304);
    const float* cw = in[13]; const float* cb = in[14];
    __syncthreads();
    for (int i = F.tid; i < M / 8; i += 512) ((LAS v4u*)T0)[i] = ((const GAS v4u*)(ZT + (size_t)c * M))[i];
    __syncthreads();
    { const float w0 = cw[c], w1 = cw[1536 + c], w2 = cw[3072 + c], bb = cb[c];
      for (int m = F.tid; m < M; m += 512) { const int t = m & (SEQ - 1);
          const float zm = t > 0 ? bf2f(T0[m - 1]) : 0.f, z0 = bf2f(T0[m]), zp = t < SEQ - 1 ? bf2f(T0[m + 1]) : 0.f;
          X0[m] = (bf16)f2bf(bb + w0 * zm + w1 * z0 + w2 * zp); } }
    __syncthreads();
    for (int i = F.tid; i < M / 8; i += 512) { ((LAS v4u*)T0)[i] = ((const GAS v4u*)(ZT + (size_t)(512 + c) * M))[i]; ((LAS v4u*)T1)[i] = ((const GAS v4u*)(ZT + (size_t)(1024 + c) * M))[i]; }
    __syncthreads();
    { const float a0 = cw[512 + c], a1 = cw[1536 + 512 + c], a2 = cw[3072 + 512 + c], ab = cb[512 + c];
      const float v0 = cw[1024 + c], v1 = cw[1536 + 1024 + c], v2 = cw[3072 + 1024 + c], vb = cb[1024 + c];
      for (int m = F.tid; m < M; m += 512) { const int t = m & (SEQ - 1);
          const float xm = t > 0 ? bf2f(T0[m - 1]) : 0.f, x0 = bf2f(T0[m]), xp = t < SEQ - 1 ? bf2f(T0[m + 1]) : 0.f;
          const float ym = t > 0 ? bf2f(T1[m - 1]) : 0.f, y0 = bf2f(T1[m]), yp = t < SEQ - 1 ? bf2f(T1[m + 1]) : 0.f;
          U[m] = (bf16)f2bf((ab + a0 * xm + a1 * x0 + a2 * xp) * (vb + v0 * ym + v1 * y0 + v2 * yp)); } }
    __syncthreads();
    const int half = F.tid >> 8, tid = F.tid & 255;
    LAS float* gs = (LAS float*)(F.lds + RING_OFF + 65536 + half * 8192);
    const bf16* g = G + (size_t)c * 16384 + 8192; const float hb = in[23][c];
    for (int vbk = half; vbk < 16; vbk += 2) { const int b = vbk >> 3, t0 = (vbk & 7) * 1024;
        float acc[4] = {0.f, 0.f, 0.f, 0.f};
        for (int s0 = 0; s0 < SEQ; s0 += 256) {
            __syncthreads();
            for (int i = tid; i < 1279; i += 256) { const int d = t0 - s0 - 255 + i; gs[i] = (d > -8192 && d < 8192) ? bf2f(g[-d]) : 0.f; }
            __syncthreads();
#pragma unroll 8
            for (int sl = 0; sl < 256; ++sl) { const float uu = bf2f(U[b * SEQ + s0 + sl]);
#pragma unroll
                for (int j = 0; j < 4; ++j) acc[j] += gs[tid + 256 * j - sl + 255] * uu; }
        }
#pragma unroll
        for (int j = 0; j < 4; ++j) { const int m = b * SEQ + t0 + tid + 256 * j;
            YT[(size_t)c * M + m] = (bf16)f2bf((acc[j] + bf2f(U[m]) * hb) * bf2f(X0[m])); }
    }
}
__device__ __forceinline__ void hy_norm_item(int m, int g, const bf16* YT, const float* og, bf16* A2) {
    float y[64]; float ss = 0.f;
#pragma unroll
    for (int ch = 0; ch < 64; ++ch) { y[ch] = bf2f(YT[(size_t)(g * 64 + ch) * M + m]); ss += y[ch] * y[ch]; }
    const float rs = rsqrtf(ss * (1.f / 64.f) + EPS);
#pragma unroll
    for (int ch = 0; ch < 64; ch += 8) { v4u w;
        w.x = pk2(y[ch] * rs * og[g * 64 + ch], y[ch + 1] * rs * og[g * 64 + ch + 1]); w.y = pk2(y[ch + 2] * rs * og[g * 64 + ch + 2], y[ch + 3] * rs * og[g * 64 + ch + 3]);
        w.z = pk2(y[ch + 4] * rs * og[g * 64 + ch + 4], y[ch + 5] * rs * og[g * 64 + ch + 5]); w.w = pk2(y[ch + 6] * rs * og[g * 64 + ch + 6], y[ch + 7] * rs * og[g * 64 + ch + 7]);
        *(GAS v4u*)(A2 + (size_t)m * D + 512 + g * 64 + ch) = w; }
}
__device__ __forceinline__ void final_norm_row(float* xrow, const float* gain, int lane) {
    f32x4 v[4]; float s = 0.f;
#pragma unroll
    for (int p = 0; p < 4; ++p) { v[p] = *(const GAS f32x4*)(xrow + p * 256 + lane * 4); s += (v[p].x * v[p].x + v[p].y * v[p].y) + (v[p].z * v[p].z + v[p].w * v[p].w); }
    const float rs = rsqrtf(wave_sum(s) * (1.f / D) + EPS);
#pragma unroll
    for (int p = 0; p < 4; ++p) { const f32x4 g = *(const GAS f32x4*)(gain + p * 256 + lane * 4);
        *(GAS f32x4*)(xrow + p * 256 + lane * 4) = (f32x4){v[p].x * rs * g.x, v[p].y * rs * g.y, v[p].z * rs * g.z, v[p].w * rs * g.w}; }
}

#ifndef SIMPLE_ATTN
#define SIMPLE_ATTN 0
#endif
#ifndef SIMPLE_CONV
#define SIMPLE_CONV 0
#endif
#ifndef DUPMASK
#define DUPMASK 0
#endif
#define REP(k) for (int rep_ = 0; rep_ < (((DUPMASK >> (k)) & 1) ? 2 : 1); ++rep_)
struct Args { const float* in[31]; float* out; unsigned char* ws; };
__global__ void __launch_bounds__(NWAVES * 64, 2) mega_fwd(Args args) {
    extern __shared__ __attribute__((aligned(16))) unsigned char lds[];
    Frame F;
    F.lds = (LAS unsigned char*)lds;
    F.MISC = (volatile LAS unsigned*)(F.lds + MISC_OFF);
    F.tid = threadIdx.x; F.lane = F.tid & 63; F.wave = __builtin_amdgcn_readfirstlane(F.tid >> 6);
    F.G = gridDim.x; { const int bx = blockIdx.x; F.vcu = (F.G % 8 == 0) ? (bx % 8) * (F.G / 8) + bx / 8 : bx; }
    unsigned char* ws = args.ws; unsigned char* dob = (unsigned char*)args.out;
    F.ctl = (gu32*)(ws + WS_CTL);
    const float* const* in = args.in;
    for (int u = F.tid; u < (LDS_BYTES - LDSCTL_OFF) / 4; u += NWAVES * 64) ((LAS unsigned*)(F.lds + LDSCTL_OFF))[u] = 0u;
    __syncthreads();
    XcdBarrier bar = xcd_barrier_post((unsigned*)(F.ctl + CW_BAR), F.MISC + 8);
#define GRID_BAR() xcd_barrier(bar)
#define RELAUNDER() do { int t_ = threadIdx.x; asm volatile("" : "+v"(t_)); F.tid = t_; F.lane = t_ & 63; } while (0)
    bf16 *Wgu1 = (bf16*)(ws + WS_WGU1), *Wd1 = (bf16*)(ws + WS_WD1), *Win = (bf16*)(ws + WS_WIN), *Wout = (bf16*)(ws + WS_WOUT), *Wgu2 = (bf16*)(ws + WS_WGU2), *Wd2 = (bf16*)(ws + WS_WD2);
    float* ssq = (float*)(ws + WS_SSQ); bf16* G = (bf16*)(ws + WS_G);
    bf16* XB = (bf16*)(ws + WS_XB); float* X1 = (float*)(ws + WS_X1); bf16* H = (bf16*)(ws + WS_H);
    bf16 *Qb = (bf16*)(ws + WS_Q), *Kb = (bf16*)(ws + WS_K), *Vb = (bf16*)(ws + WS_V), *A2 = (bf16*)(ws + WS_A2);
    bf16* ZT = (bf16*)(dob + DO_ZT); bf16* YT = (bf16*)(dob + DO_YT);

    RELAUNDER();
    REP(0) p0_early(F, in, ws);
    GRID_BAR();
    REP(1) { pg8::Gemm g{XB, Wgu1, M, 2 * FF, D}; pg8::StaticOrder S; S.init(M, 2 * FF, F.G, (int)blockIdx.x);
      pg8::EpiSwiglu E{H, FF, ssq};
      pg8::gemm_phase<pg8::EpiSwiglu, pg8::StaticOrder, true, true>(F.lds + RING_OFF, g, S, E); }
    RELAUNDER();
    REP(8) { __syncthreads(); for (int u = F.vcu; u < SEQ / 32; u += F.G) p0_filters_unit(F, in, G, u); }
    REP(7) { const int nwg = (M / 256) * (2 * FF / 256), nfull = nwg % F.G;
      if (nfull == 0) p0_late(F, in, ws, (int)blockIdx.x, F.G); else if ((int)blockIdx.x >= nfull) p0_late(F, in, ws, (int)blockIdx.x - nfull, F.G - nfull); }
    GRID_BAR();
    REP(2) { pg8::Gemm g{H, Wd1, M, D, FF}; pg8::StaticOrder S; S.init(M, D, F.G, (int)blockIdx.x);
      pg8::EpiResid E{in[0], X1, XB, ssq, 0.5f};
      pg8::gemm_phase<pg8::EpiResid, pg8::StaticOrder, false, true>(F.lds + RING_OFF, g, S, E); }
    GRID_BAR();
    REP(3) { pg8::Gemm g{XB, Win, M, 1536, D}; pg8::StaticOrder S; S.init(M, 1536, F.G, (int)blockIdx.x);
      pg8::EpiQKV E{Qb, (size_t)(WS_K - WS_Q) / 2, ssq, C2};
      pg8::gemm_phase<pg8::EpiQKV, pg8::StaticOrder, true, true>(F.lds + RING_OFF, g, S, E); }
    __syncthreads();
    { pg8::Gemm g{Win + (size_t)1536 * D, XB, 1536, M, D}; pg8::StaticOrder S; S.init(1536, M, F.G, (int)blockIdx.x);
      pg8::EpiZT E{ZT, M, ssq};
      pg8::gemm_phase<pg8::EpiZT, pg8::StaticOrder, true, true>(F.lds + RING_OFF, g, S, E); }
    GRID_BAR();
#if SIMPLE_ATTN
    for (int vb = 2 * F.vcu + (F.tid >> 8); vb < BATCH * NH * (SEQ / 32); vb += 2 * F.G) attn_simple_pair(F, vb, Qb, Kb, Vb, in, A2);
#else
    REP(4) { float s1 = 0.f, s2 = 0.f;
      for (int i = 0; i < 64; ++i) { s1 += in[8][i] * in[9][i]; s2 += in[10][i] * in[11][i]; }
      const float lam = expf(s1) - expf(s2) + 0.2f;
      for (int u = F.vcu; u < 256; u += F.G) att::attn_unit<8>(F.lds + RING_OFF, u >> 7, (u >> 5) & 3, u & 31, Qb, Kb, Vb, in[1], lam, in[12], (float*)(ws + WS_XB), A2); }
#endif
#if SIMPLE_CONV
    for (int c = F.vcu; c < 512; c += F.G) hyena_simple_channel(F, c, ZT, G, in, YT);
#else
    RELAUNDER();
    REP(6) for (int c = F.vcu; c < 512; c += F.G) hyc::conv_channel(F.lds + RING_OFF, c, ZT, G, in[13], in[14], in[23][c], YT);
#endif
    GRID_BAR();
    RELAUNDER();
    REP(5) for (int it = F.vcu * 512 + F.tid; it < M * 8; it += F.G * 512) hy_norm_item(it % M, it / M, YT, in[24], A2);
    GRID_BAR();
    { pg8::Gemm g{A2, Wout, M, D, D}; pg8::StaticOrder S; S.init(M, D, F.G, (int)blockIdx.x);
      pg8::EpiResid E{X1, X1, XB, ssq, 1.0f};
      pg8::gemm_phase<pg8::EpiResid, pg8::StaticOrder, false, true>(F.lds + RING_OFF, g, S, E); }
    GRID_BAR();
    { pg8::Gemm g{XB, Wgu2, M, 2 * FF, D}; pg8::StaticOrder S; S.init(M, 2 * FF, F.G, (int)blockIdx.x);
      pg8::EpiSwiglu E{H, FF, ssq};
      pg8::gemm_phase<pg8::EpiSwiglu, pg8::StaticOrder, true, true>(F.lds + RING_OFF, g, S, E); }
    GRID_BAR();
    { pg8::Gemm g{H, Wd2, M, D, FF}; pg8::StaticOrder S; S.init(M, D, F.G, (int)blockIdx.x);
      pg8::EpiResid E{X1, args.out, nullptr, nullptr, 0.5f};
      pg8::gemm_phase<pg8::EpiResid, pg8::StaticOrder, false, true>(F.lds + RING_OFF, g, S, E); }
    GRID_BAR();
    RELAUNDER();
    { const int gw = F.vcu * NWAVES + F.wave, NGW = F.G * NWAVES;
      for (int m = gw; m < M; m += NGW) final_norm_row(args.out + (size_t)m * D, in[30], F.lane); }
}

extern "C" void kernel_launch(void* const* d_in, const int* in_sizes, int n_in, void* d_out, int out_size, void* d_ws, size_t ws_size, hipStream_t stream) {
    static int grid = 0;
    if (grid == 0) {
        if (n_in != 31 || in_sizes[0] != M * D || out_size != M * D || ws_size < WS_END) { fprintf(stderr, "kernel_launch: unexpected shapes (n_in %d, ws %zu); nothing launched\n", n_in, ws_size); grid = -1; return; }
        int dev = 0, cus = 0, per_cu = 0;
        if (hipGetDevice(&dev) != hipSuccess || hipDeviceGetAttribute(&cus, hipDeviceAttributeMultiprocessorCount, dev) != hipSuccess) { grid = -1; return; }
        if (hipFuncSetAttribute((const void*)mega_fwd, hipFuncAttributeMaxDynamicSharedMemorySize, LDS_BYTES) != hipSuccess) { fprintf(stderr, "kernel_launch: hipFuncSetAttribute failed\n"); grid = -1; return; }
        if (hipOccupancyMaxActiveBlocksPerMultiprocessor(&per_cu, (const void*)mega_fwd, NWAVES * 64, LDS_BYTES) != hipSuccess || per_cu < 1)
            fprintf(stderr, "kernel_launch: note: occupancy query reports %d workgroups per CU\n", per_cu);
        (void)hipGetLastError();
        grid = cus;
        if (grid != 256) fprintf(stderr, "kernel_launch: %d CUs; the residual GEMM phases need exactly 256 workgroups\n", grid);
    }
    if (grid < 0) return;
    (void)hipMemsetAsync((char*)d_ws + WS_CTL, 0, CTL_ZERO_BYTES, stream);
    Args a{};
    for (int i = 0; i < 31; ++i) a.in[i] = (const float*)d_in[i];
    a.out = (float*)d_out; a.ws = (unsigned char*)d_ws;
    hipLaunchKernelGGL(mega_fwd, dim3(grid), dim3(NWAVES * 64), LDS_BYTES, stream, a);
}
```

```cpp
#include <hip/hip_runtime.h>
#include <cstdio>
#include <cstdint>
#include <cmath>
namespace pg8 {
#define PG8_LAS __attribute__((address_space(3)))
typedef unsigned short bf16_t;
typedef short bf16x8 __attribute__((ext_vector_type(8)));
typedef float f32x4 __attribute__((ext_vector_type(4)));
typedef unsigned u32x4 __attribute__((ext_vector_type(4)));
constexpr int BM = 256, BK = 64, HALF = 128, HTB = HALF * BK * 2  , STAGE_BYTES = 8 * HTB, NXCD = 8, WGM = 8;

__host__ __device__ __forceinline__ int lds_byte(int r, int c) { const int st = (r >> 4) * 2 + (c >> 5), rr = r & 15, cc = c & 31, ob = rr * 64 + cc * 2; return st * 1024 + (ob ^ (((ob >> 9) & 1) << 5)); }
__host__ __device__ __forceinline__ void stage_rc(int b, int& R, int& C) { const int st = b / 1024, sb = b % 1024, swz = sb ^ (((sb >> 9) & 1) << 5); R = (st >> 1) * 16 + swz / 64; C = (st & 1) * 32 + (swz % 64) / 2; }
__host__ __device__ __forceinline__ int perm32(int rho) { const int n = rho >> 4, i = rho & 15; return 8 * (i >> 2) + 4 * n + (i & 3); }

struct Unit { int pm, pn; };
struct Gemm { const bf16_t* A; const bf16_t* Bt; int M, N, K; };

struct StaticOrder {
    int nM, nN, nwg, G, c;
    __host__ __device__ void init(int M, int N, int G_, int c_) { nM = M / BM; nN = N / BM; nwg = nM * nN; G = G_; c = c_; }
    __host__ __device__ bool next(int i, Unit& u) const {
        const long L = (long)i * G + c; if (L >= nwg) return false;
        int wgid = (int)L; { const int q = nwg / NXCD, r = nwg % NXCD, xcd = wgid % NXCD, off = wgid / NXCD; wgid = (xcd < r ? xcd * (q + 1) : r * (q + 1) + (xcd - r) * q) + off; }
        const int nig = WGM * nN, gid = wgid / nig, fm = gid * WGM, gsz = (nM - fm) < WGM ? (nM - fm) : WGM;
        u.pm = fm + ((wgid % nig) % gsz); u.pn = (wgid % nig) / gsz; return true;
    }
    __device__ __forceinline__ void a_ready(const Unit&) const {}
    __device__ __forceinline__ void done(const Unit&) const {}
};

__device__ __forceinline__ unsigned cvt_pk_bf16(float lo, float hi) { unsigned r; asm volatile("v_cvt_pk_bf16_f32 %0, %1, %2" : "=v"(r) : "v"(lo), "v"(hi)); return r; }
constexpr float RMS_EPS = 1e-6f;
__device__ __forceinline__ float rstd_row(const float* ssq, int row) { const f32x4 s = *(const f32x4*)(ssq + (size_t)row * 4); return __builtin_amdgcn_rsqf(((s[0] + s[1]) + (s[2] + s[3])) * (1.0f / 1024.0f) + RMS_EPS); }
__device__ __forceinline__ float silu_mul(float g, float u) { return g * __builtin_amdgcn_rcpf(1.0f + __builtin_amdgcn_exp2f(-1.4426950408889634f * g)) * u; }

struct EpiSwiglu {
    static constexpr bool PERM = true, AFTER_DRAIN = false;
    bf16_t* H; int ldh; const float* ssq;
    __device__ __forceinline__ void operator()(const f32x4 (&acc)[2][2][4][2], const Unit& u, int wr, int wc, int fr, int fq) const {
        const int row0 = u.pm * BM + wr * 64 + fr, col0 = u.pn * HALF + wc * 32 + 8 * fq;
#pragma unroll
        for (int ai = 0; ai < 2; ++ai)
#pragma unroll
            for (int m = 0; m < 4; ++m) { const int row = row0 + ai * HALF + m * 16; const float rs = rstd_row(ssq, row);
                const f32x4 g0 = acc[ai][0][m][0] * rs, g1 = acc[ai][0][m][1] * rs, u0 = acc[ai][1][m][0] * rs, u1 = acc[ai][1][m][1] * rs;
                u32x4 w; w.x = cvt_pk_bf16(silu_mul(g0[0], u0[0]), silu_mul(g0[1], u0[1])); w.y = cvt_pk_bf16(silu_mul(g0[2], u0[2]), silu_mul(g0[3], u0[3]));
                w.z = cvt_pk_bf16(silu_mul(g1[0], u1[0]), silu_mul(g1[1], u1[1])); w.w = cvt_pk_bf16(silu_mul(g1[2], u1[2]), silu_mul(g1[3], u1[3]));
                *(u32x4*)(H + (size_t)row * ldh + col0) = w; }
    }
};
struct EpiQKV {
    static constexpr bool PERM = true, AFTER_DRAIN = false;
    bf16_t* Q; size_t qkv_stride; const float* ssq; float qscale;
    __device__ __forceinline__ void operator()(const f32x4 (&acc)[2][2][4][2], const Unit& u, int wr, int wc, int fr, int fq) const {
        const int row0 = u.pm * BM + wr * 64 + fr; const int t = u.pn >> 1; bf16_t* base = Q + (size_t)t * qkv_stride; const float sc = t == 0 ? qscale : 1.0f;
        const int col0 = (u.pn & 1) * BM + wc * 32 + 8 * fq;
#pragma unroll
        for (int ai = 0; ai < 2; ++ai)
#pragma unroll
            for (int m = 0; m < 4; ++m) { const int row = row0 + ai * HALF + m * 16; const float rs = rstd_row(ssq, row) * sc;
#pragma unroll
                for (int bj = 0; bj < 2; ++bj) { const f32x4 v0 = acc[ai][bj][m][0] * rs, v1 = acc[ai][bj][m][1] * rs;
                    u32x4 w; w.x = cvt_pk_bf16(v0[0], v0[1]); w.y = cvt_pk_bf16(v0[2], v0[3]); w.z = cvt_pk_bf16(v1[0], v1[1]); w.w = cvt_pk_bf16(v1[2], v1[3]);
                    *(u32x4*)(base + (size_t)row * 512 + col0 + bj * HALF) = w; } }
    }
};
struct EpiZT {
    static constexpr bool PERM = true, AFTER_DRAIN = false;
    bf16_t* ZT; int ldz; const float* ssq;
    __device__ __forceinline__ void operator()(const f32x4 (&acc)[2][2][4][2], const Unit& u, int wr, int wc, int fr, int fq) const {
        const int row0 = u.pm * BM + wr * 64 + fr, col0 = u.pn * BM + wc * 32 + 8 * fq;
#pragma unroll
        for (int bj = 0; bj < 2; ++bj) { float cs[8];
#pragma unroll
            for (int j = 0; j < 8; ++j) cs[j] = rstd_row(ssq, col0 + bj * HALF + j);
#pragma unroll
            for (int ai = 0; ai < 2; ++ai)
#pragma unroll
                for (int m = 0; m < 4; ++m) { const int row = row0 + ai * HALF + m * 16; const f32x4 v0 = acc[ai][bj][m][0], v1 = acc[ai][bj][m][1];
                    u32x4 w; w.x = cvt_pk_bf16(v0[0] * cs[0], v0[1] * cs[1]); w.y = cvt_pk_bf16(v0[2] * cs[2], v0[3] * cs[3]);
                    w.z = cvt_pk_bf16(v1[0] * cs[4], v1[1] * cs[5]); w.w = cvt_pk_bf16(v1[2] * cs[6], v1[3] * cs[7]);
                    *(u32x4*)(ZT + (size_t)row * ldz + col0 + bj * HALF) = w; }
            asm volatile("" ::: "memory"); }
    }
};
struct EpiResid {
    static constexpr bool PERM = false, AFTER_DRAIN = true;
    const float* Xin; float* Xout; bf16_t* XB; float* ssq; float scale;
    __device__ __forceinline__ void fused(f32x4 (&acc)[2][2][4][2], const Unit& u, int wr, int wc, int fr, int fq, PG8_LAS unsigned char* lds, int wid, int lane) const {
        typedef unsigned u32x2v __attribute__((ext_vector_type(2)));
        PG8_LAS float* P = (PG8_LAS float*)lds;
        const int col0 = u.pn * BM + wc * 32 + 4 * fq;
#pragma unroll
        for (int ai = 0; ai < 2; ++ai)
#pragma unroll
            for (int m = 0; m < 4; ++m) { const int r = ai * HALF + wr * 64 + m * 16 + fr; const size_t off = (size_t)(u.pm * BM + r) * 1024 + col0; float ss = 0.f;
#pragma unroll
                for (int bj = 0; bj < 2; ++bj)
#pragma unroll
                    for (int n = 0; n < 2; ++n) { const size_t o = off + bj * HALF + n * 16; const f32x4 v = *(const f32x4*)(Xin + o) + acc[ai][bj][m][n] * scale;
                        *(f32x4*)(Xout + o) = v; ss += (v[0] * v[0] + v[1] * v[1]) + (v[2] * v[2] + v[3] * v[3]);
                        if (XB) { u32x2v w; w.x = cvt_pk_bf16(v[0], v[1]); w.y = cvt_pk_bf16(v[2], v[3]); *(u32x2v*)(XB + o) = w; } }
                ss += __shfl_xor(ss, 16); ss += __shfl_xor(ss, 32);
                if (fq == 0) P[r * 4 + wc] = ss;
                if (m & 1) asm volatile("" ::: "memory"); }
        asm volatile("s_waitcnt lgkmcnt(0)" ::: "memory"); __builtin_amdgcn_s_barrier(); asm volatile("" ::: "memory");
        if (ssq) { const int row = wid * 64 + lane; if (row < 256) { const f32x4 p = *(const PG8_LAS f32x4*)(P + row * 4); ssq[(size_t)(u.pm * BM + row) * 4 + u.pn] = (p[0] + p[1]) + (p[2] + p[3]); } }
        asm volatile("s_waitcnt lgkmcnt(0)" ::: "memory"); __builtin_amdgcn_s_barrier(); asm volatile("" ::: "memory");
    }
};

template <class Epi, class Sched, bool ALIGN_EPI = false, bool SP2 = false>
__device__ __forceinline__ void gemm_phase(PG8_LAS unsigned char* lds, const Gemm g, const Sched& S, const Epi& E) {
    int tid_ = threadIdx.x; asm volatile("" : "+v"(tid_));
    const int tid = tid_, wid = __builtin_amdgcn_readfirstlane(tid >> 6), lane = tid & 63, wr = wid >> 2, wc = wid & 3, fr = lane & 15, fq = lane >> 4;
    const int K = g.K, nt = K / BK;
    unsigned voffA[2], voffB[2];
#pragma unroll
    for (int i = 0; i < 2; ++i) { int R, C; stage_rc(tid * 16 + i * 8192, R, C); const int Rb = Epi::PERM ? ((R & ~31) + perm32(R & 31)) : R;
        voffA[i] = (unsigned)(R * K + C) * 2u; voffB[i] = (unsigned)(Rb * K + C) * 2u; }
    const size_t kstep = (size_t)(BK * 2);
    const size_t hstep = (size_t)HALF * K * 2;
    const size_t tstep = 2 * hstep;
    const unsigned ldsw = (unsigned)wid * 1024u;
    const int aoff = lds_byte(wr * 64 + fr, fq * 8), boff = lds_byte(wc * 32 + fr, fq * 8);
#define PG8_SA(b, h) (((b) * 2 + (h)) * HTB)
#define PG8_SB(b, h) ((4 + (b) * 2 + (h)) * HTB)
#define PG8_STAGE(bufoff, gbase, voff) do { _Pragma("unroll") for (int _i = 0; _i < 2; ++_i) \
        __builtin_amdgcn_global_load_lds((const unsigned*)((const char*)(gbase) + (voff)[_i]), (PG8_LAS unsigned*)(lds + (bufoff) + ldsw + _i * 8192), 16, 0, 0); } while (0)
#define PG8_LDA(dst, b, h) do { _Pragma("unroll") for (int m = 0; m < 4; ++m) _Pragma("unroll") for (int k = 0; k < 2; ++k) dst[m][k] = *(const PG8_LAS bf16x8*)(lds + PG8_SA(b, h) + aoff + m * 2048 + k * 1024); } while (0)
#define PG8_LDB(dst, b, h) do { _Pragma("unroll") for (int n = 0; n < 2; ++n) _Pragma("unroll") for (int k = 0; k < 2; ++k) dst[n][k] = *(const PG8_LAS bf16x8*)(lds + PG8_SB(b, h) + boff + n * 2048 + k * 1024); } while (0)
#define PG8_MMA(ai, bj, At, Bt) do { __builtin_amdgcn_s_setprio(1); _Pragma("unroll") for (int m = 0; m < 4; ++m) _Pragma("unroll") for (int n = 0; n < 2; ++n) _Pragma("unroll") for (int k = 0; k < 2; ++k) \
        acc[ai][bj][m][n] = __builtin_amdgcn_mfma_f32_16x16x32_bf16(Bt[n][k], At[m][k], acc[ai][bj][m][n], 0, 0, 0); __builtin_amdgcn_s_setprio(0); } while (0)
#define PG8_WAIT_V(n) asm volatile("s_waitcnt vmcnt(" #n ")" ::: "memory")
#define PG8_WAIT_L(n) asm volatile("s_waitcnt lgkmcnt(" #n ")" ::: "memory")
#define PG8_BAR __builtin_amdgcn_s_barrier()
#define PG8_SCHED __builtin_amdgcn_sched_barrier(0)
    Unit cur, nxt; int ui = 0;
    if (!S.next(0, cur)) return;
    f32x4 acc[2][2][4][2];
#pragma unroll
    for (int a = 0; a < 2; ++a)
#pragma unroll
        for (int b = 0; b < 2; ++b)
#pragma unroll
            for (int m = 0; m < 4; ++m)
#pragma unroll
                for (int n = 0; n < 2; ++n) acc[a][b][m][n] = (f32x4){0.f, 0.f, 0.f, 0.f};
    bf16x8 At[4][2], B0[2][2], B1[2][2];
    const char* cA = (const char*)g.A + (size_t)cur.pm * tstep; const char* cB = (const char*)g.Bt + (size_t)cur.pn * tstep;
    S.a_ready(cur);
    if constexpr (SP2) {
        PG8_STAGE(PG8_SB(0, 0), cB, voffB); PG8_STAGE(PG8_SB(0, 1), cB + hstep, voffB); PG8_STAGE(PG8_SA(0, 0), cA, voffA); PG8_STAGE(PG8_SA(0, 1), cA + hstep, voffA);
        if (wr == 1) PG8_BAR;
        PG8_WAIT_V(2); PG8_BAR;
        PG8_STAGE(PG8_SB(1, 0), cB + kstep, voffB); PG8_STAGE(PG8_SA(1, 0), cA + kstep, voffA); PG8_STAGE(PG8_SB(1, 1), cB + hstep + kstep, voffB);
        PG8_WAIT_V(6); PG8_BAR;
    } else {
        PG8_STAGE(PG8_SB(0, 0), cB, voffB); PG8_STAGE(PG8_SA(0, 0), cA, voffA); PG8_STAGE(PG8_SB(0, 1), cB + hstep, voffB); PG8_STAGE(PG8_SA(0, 1), cA + hstep, voffA);
        if (wr == 1) PG8_BAR;
        PG8_WAIT_V(4); PG8_BAR;
        PG8_STAGE(PG8_SB(1, 0), cB + kstep, voffB); PG8_STAGE(PG8_SA(1, 0), cA + kstep, voffA); PG8_STAGE(PG8_SB(1, 1), cB + hstep + kstep, voffB);
        PG8_WAIT_V(6); PG8_BAR;
    }
    for (;;) {
        const bool has_next = S.next(ui + 1, nxt);
        const char* nA = has_next ? (const char*)g.A + (size_t)nxt.pm * tstep : cA; const char* nB = has_next ? (const char*)g.Bt + (size_t)nxt.pn * tstep : cB;
        for (int t = 0; t < nt; t += 2) {
            const bool last = (t == nt - 2);
            const char* a1 = cA + (size_t)(t + 1) * kstep;
            const char* a2 = last ? nA : cA + (size_t)(t + 2) * kstep; const char* b2 = last ? nB : cB + (size_t)(t + 2) * kstep;
            const char* a3 = a2 + kstep; const char* b3 = b2 + kstep;
            if (last && has_next) S.a_ready(nxt);
            if constexpr (SP2) {
            PG8_LDB(B0, 0, 0); PG8_LDB(B1, 0, 1); PG8_SCHED; PG8_LDA(At, 0, 0); PG8_STAGE(PG8_SA(1, 1), a1 + hstep, voffA);
            PG8_WAIT_V(8); PG8_WAIT_L(0); PG8_BAR; PG8_MMA(0, 0, At, B0); PG8_MMA(0, 1, At, B1); PG8_BAR; PG8_SCHED;
            PG8_LDA(At, 0, 1); PG8_STAGE(PG8_SB(0, 0), b2, voffB); PG8_STAGE(PG8_SB(0, 1), b2 + hstep, voffB); PG8_STAGE(PG8_SA(0, 0), a2, voffA);
            PG8_WAIT_V(8); PG8_WAIT_L(0); PG8_BAR; PG8_MMA(1, 0, At, B0); PG8_MMA(1, 1, At, B1); PG8_BAR; PG8_SCHED;
            PG8_LDB(B0, 1, 0); PG8_LDB(B1, 1, 1); PG8_SCHED; PG8_LDA(At, 1, 0); PG8_STAGE(PG8_SA(0, 1), a2 + hstep, voffA);
            PG8_WAIT_V(8); PG8_WAIT_L(0); PG8_BAR; PG8_MMA(0, 0, At, B0); PG8_MMA(0, 1, At, B1); PG8_BAR; PG8_SCHED;
            PG8_LDA(At, 1, 1); PG8_STAGE(PG8_SB(1, 0), b3, voffB); PG8_STAGE(PG8_SB(1, 1), b3 + hstep, voffB); PG8_STAGE(PG8_SA(1, 0), a3, voffA);
            PG8_WAIT_V(8); PG8_WAIT_L(0); PG8_BAR; PG8_MMA(1, 0, At, B0); PG8_MMA(1, 1, At, B1); PG8_BAR; PG8_SCHED;
            } else {
            PG8_LDB(B0, 0, 0); PG8_SCHED; PG8_LDA(At, 0, 0); PG8_STAGE(PG8_SA(1, 1), a1 + hstep, voffA);
            PG8_WAIT_L(8); PG8_BAR; PG8_WAIT_L(0); PG8_MMA(0, 0, At, B0); PG8_BAR; PG8_SCHED;
            PG8_LDB(B1, 0, 1); PG8_STAGE(PG8_SB(0, 0), b2, voffB);
            PG8_BAR; PG8_WAIT_L(0); PG8_MMA(0, 1, At, B1); PG8_BAR;
            PG8_LDA(At, 0, 1); PG8_STAGE(PG8_SA(0, 0), a2, voffA);
            PG8_BAR; PG8_WAIT_L(0); PG8_MMA(1, 0, At, B0); PG8_BAR; PG8_SCHED;
            PG8_STAGE(PG8_SB(0, 1), b2 + hstep, voffB);
            PG8_WAIT_V(6); PG8_BAR; PG8_MMA(1, 1, At, B1); PG8_BAR;
            PG8_LDB(B0, 1, 0); PG8_SCHED; PG8_LDA(At, 1, 0); PG8_STAGE(PG8_SA(0, 1), a2 + hstep, voffA);
            PG8_WAIT_L(8); PG8_BAR; PG8_WAIT_L(0); PG8_MMA(0, 0, At, B0); PG8_BAR; PG8_SCHED;
            PG8_LDB(B1, 1, 1); PG8_STAGE(PG8_SB(1, 0), b3, voffB);
            PG8_BAR; PG8_WAIT_L(0); PG8_MMA(0, 1, At, B1); PG8_BAR;
            PG8_LDA(At, 1, 1); PG8_STAGE(PG8_SA(1, 0), a3, voffA);
            PG8_BAR; PG8_WAIT_L(0); PG8_MMA(1, 0, At, B0); PG8_BAR; PG8_SCHED;
            PG8_STAGE(PG8_SB(1, 1), b3 + hstep, voffB);
            PG8_WAIT_V(6); PG8_BAR; PG8_MMA(1, 1, At, B1); PG8_BAR;
            }
        }
        if constexpr (ALIGN_EPI) { if (wr == 0) PG8_BAR; }
        if constexpr (!Epi::AFTER_DRAIN) { E(acc, cur, wr, wc, fr, fq); S.done(cur); }
        if (!has_next) break;
#pragma unroll
        for (int a = 0; a < 2; ++a)
#pragma unroll
            for (int b = 0; b < 2; ++b)
#pragma unroll
                for (int m = 0; m < 4; ++m)
#pragma unroll
                    for (int n = 0; n < 2; ++n) acc[a][b][m][n] = (f32x4){0.f, 0.f, 0.f, 0.f};
        cur = nxt; cA = nA; cB = nB; ++ui;
        if constexpr (ALIGN_EPI) { if (wr == 1) PG8_BAR; }
    }
    PG8_WAIT_V(0);
    if constexpr (!ALIGN_EPI) { if (wr == 0) PG8_BAR; }
    PG8_BAR;
    if constexpr (Epi::AFTER_DRAIN) { E.fused(acc, cur, wr, wc, fr, fq, lds, wid, lane); S.done(cur); }
#undef PG8_SA
#undef PG8_SB
#undef PG8_STAGE
#undef PG8_LDA
#undef PG8_LDB
#undef PG8_MMA
#undef PG8_WAIT_V
#undef PG8_WAIT_L
#undef PG8_BAR
#undef PG8_SCHED
}
}
#define GAS __attribute__((address_space(1)))
#define LAS __attribute__((address_space(3)))
typedef unsigned short bf16;
typedef unsigned v4u __attribute__((ext_vector_type(4)));
typedef float f32x4 __attribute__((ext_vector_type(4)));
typedef short bf16x8 __attribute__((ext_vector_type(8)));
typedef GAS unsigned gu32;
typedef GAS unsigned long long gu64;
#define RLX_AGENT __ATOMIC_RELAXED, __HIP_MEMORY_SCOPE_AGENT
#define LDS_WAIT() asm volatile("s_waitcnt lgkmcnt(0)" ::: "memory")
#define VM_WAIT() asm volatile("s_waitcnt vmcnt(0)" ::: "memory")
__device__ __forceinline__ unsigned long long rt() { return __builtin_amdgcn_s_memrealtime(); }
__device__ __forceinline__ unsigned f2bf(float f) { unsigned u = __builtin_bit_cast(unsigned, f); return (u + 0x7fffu + ((u >> 16) & 1u)) >> 16; }
__device__ __forceinline__ unsigned pk2(float lo, float hi) { return f2bf(lo) | (f2bf(hi) << 16); }

#define XB_TMO      128
#define XB_XCNT(j)  (256  + 64 * (j))
#define XB_XSUB(j)  (1280 + 64 * (j))
#define XB_XGEN(j)  (2304 + 64 * (j))
#define XB_TOP      3328
#define XB_TOPGEN   3392
#define XCD_BAR_WORDS 3456
#define XB_SPIN_CAP (1u << 18)

__device__ __forceinline__ unsigned xb_ld(unsigned* p)              { return __hip_atomic_load(p, __ATOMIC_RELAXED, __HIP_MEMORY_SCOPE_AGENT); }
__device__ __forceinline__ unsigned xb_add(unsigned* p, unsigned v) { return __hip_atomic_fetch_add(p, v, __ATOMIC_RELAXED, __HIP_MEMORY_SCOPE_AGENT); }
__device__ __forceinline__ unsigned xb_xcc_id() { return (unsigned)__builtin_amdgcn_s_getreg((3 << 11) | 20) & 0xFu; }
#define XB_SPIN(cond, bar) do { unsigned _sp = 0; while (cond) { __builtin_amdgcn_s_sleep(1); \
    if ((++_sp & 255u) == 0u) { if (xb_ld(&(bar)[XB_TMO])) break; if (_sp > XB_SPIN_CAP) { atomicAdd(&(bar)[XB_TMO], 1u); break; } } } } while (0)

struct XcdBarrier {
    unsigned* bar; unsigned x;
    volatile LAS unsigned* st;
};

__device__ __forceinline__ XcdBarrier xcd_barrier_post(unsigned* bar, volatile LAS unsigned* st) {
    XcdBarrier b; b.bar = bar; b.x = xb_xcc_id(); b.st = st;
    if (threadIdx.x == 0) (void)xb_add(&bar[XB_XCNT(b.x)], 1u);
    return b;
}
__device__ __forceinline__ void xcd_barrier_complete(unsigned* bar, unsigned x, unsigned& nloc, unsigned& nx) {
    const unsigned G = gridDim.x * gridDim.y * gridDim.z;
    unsigned sum, cnt, mine, sp = 0u;
    for (;;) {
        sum = 0u; cnt = 0u; mine = 0u;
#pragma unroll
        for (unsigned j = 0; j < 16; ++j) { const unsigned c = xb_ld(&bar[XB_XCNT(j)]); sum += c; cnt += (c > 0u) ? 1u : 0u; mine = (j == x) ? c : mine; }
        if (sum == G) break;
        __builtin_amdgcn_s_sleep(1);
        if ((++sp & 255u) == 0u) { if (xb_ld(&bar[XB_TMO])) break; if (sp > XB_SPIN_CAP) { atomicAdd(&bar[XB_TMO], 1u); break; } }
    }
    nloc = mine > 0u ? mine : 1u; nx = cnt > 0u ? cnt : 1u;
}

__device__ __forceinline__ void xcd_barrier(const XcdBarrier& b) {
    asm volatile("s_waitcnt vmcnt(0)" ::: "memory");
    __syncthreads();
    if (threadIdx.x == 0) {
        unsigned* bar = b.bar;
        __builtin_amdgcn_s_waitcnt(0);
        unsigned nloc = b.st[0], nx = b.st[1];
        if (nloc == 0u) { xcd_barrier_complete(bar, b.x, nloc, nx); b.st[0] = nloc; b.st[1] = nx; }
        const unsigned old = xb_add(&bar[XB_XSUB(b.x)], 1u);
        const unsigned gen = old / nloc;
        if (old + 1u == (gen + 1u) * nloc) {
            __builtin_amdgcn_fence(__ATOMIC_RELEASE, "agent");
            asm volatile("s_waitcnt vmcnt(0)" ::: "memory");
            const unsigned og = xb_add(&bar[XB_TOP], 1u);
            const unsigned tg = og / nx;
            if (og + 1u == (tg + 1u) * nx) xb_add(&bar[XB_TOPGEN], 1u);
            else XB_SPIN(xb_ld(&bar[XB_TOPGEN]) == tg, bar);
            __builtin_amdgcn_fence(__ATOMIC_ACQUIRE, "agent");
            xb_add(&bar[XB_XGEN(b.x)], 1u);
            asm volatile("s_waitcnt vmcnt(0)" ::: "memory");
        } else {
            XB_SPIN(xb_ld(&bar[XB_XGEN(b.x)]) == gen, bar);
            __builtin_amdgcn_fence(__ATOMIC_ACQUIRE, "agent");
            asm volatile("s_waitcnt vmcnt(0)" ::: "memory");
        }
    }
    __syncthreads();
}

namespace att {
#define ATT_LAS __attribute__((address_space(3)))
typedef short bf16x8 __attribute__((ext_vector_type(8)));
typedef short s16x4 __attribute__((ext_vector_type(4)));
typedef short v4i16_t __attribute__((ext_vector_type(4)));
typedef float f32x16 __attribute__((ext_vector_type(16)));
typedef unsigned u32x4 __attribute__((ext_vector_type(4)));
typedef unsigned short bf16_t;
constexpr int SEQ = 8192, NT = SEQ / 64;
constexpr int KSLOT = 8192, VSLOT = 16384;
constexpr int L_K = 0, L_V = 2 * KSLOT, L_WS = L_V + 2 * VSLOT, L_BT = L_WS + 8 * 64 * 4, L_OST = L_BT + 2048, L_END = L_OST + 8 * 8192;
static_assert(L_END <= 131072, "attention LDS map");
__device__ __forceinline__ int crow(int r, int hi) { return (r & 3) + 8 * (r >> 2) + 4 * hi; }
__device__ __forceinline__ unsigned cvtpk(float lo, float hi) { typedef float f2 __attribute__((ext_vector_type(2))); typedef __bf16 b2 __attribute__((ext_vector_type(2))); f2 v = {lo, hi}; b2 b = __builtin_convertvector(v, b2); return __builtin_bit_cast(unsigned, b); }
__device__ __forceinline__ s16x4 vtr(const ATT_LAS unsigned char* p) { return __builtin_bit_cast(s16x4, __builtin_amdgcn_ds_read_tr16_b64_v4i16((ATT_LAS v4i16_t*)p)); }
__device__ __forceinline__ int t5_bucket(int rel) {
    const int n = rel < 0 ? -rel : rel; int b;
    if (n < 8) b = n; else if (n < 12) b = 8; else if (n < 16) b = 9; else if (n < 23) b = 10; else if (n < 32) b = 11;
    else if (n < 46) b = 12; else if (n < 64) b = 13; else if (n < 91) b = 14; else b = 15;
    return b + (rel > 0 ? 16 : 0);
}
#define ATT_WAIT_BAR() asm volatile("s_waitcnt vmcnt(0) lgkmcnt(0)\n\ts_barrier" ::: "memory")
#define ATT_MFMA(a, b, c) __builtin_amdgcn_mfma_f32_32x32x16_bf16((a), (b), (c), 0, 0, 0)

template <int THRL>
__device__ __forceinline__ void attn_unit(ATT_LAS unsigned char* lds, int b, int h, int qb, const bf16_t* Q, const bf16_t* K, const bf16_t* V, const float* rel_bias,
                                          float lam, const float* subln, float* stash, bf16_t* A2) {
    int tid_ = threadIdx.x; asm volatile("" : "+v"(tid_));
    const int tid = tid_, lane = tid & 63, r32 = lane & 31, hi = lane >> 5; const int wid = __builtin_amdgcn_readfirstlane(tid >> 6);
    const size_t rowbase = (size_t)b * SEQ; const int q0 = qb * 256 + wid * 32;
    ATT_LAS float* wsf = (ATT_LAS float*)(lds + L_WS) + wid * 64;
    ATT_LAS float* btab = (ATT_LAS float*)(lds + L_BT);
    __syncthreads();
    for (int i = tid; i < 257; i += 512) btab[i] = rel_bias[t5_bucket(i - 128) * 4 + h] * 1.4426950408889634f;
    __syncthreads();
    const float bl = btab[0], br = btab[256];
    const unsigned ldsw = (unsigned)wid * 1024u;
    const unsigned vpiece = (unsigned)(((wid >> 2) * 4 + (wid & 3)) * 1024);
    const int vrd = ((lane >> 4) & 1) * 32 + (lane & 3) * 8 + (4 * hi + ((lane & 15) >> 2)) * 64;
    const int krd = hi * 1024 + r32 * 16;
#pragma unroll 1
    for (int c = 0; c < 2; ++c) {
        const bf16_t* Qw = Q + (rowbase + q0) * 512 + h * 128 + c * 64;
        const bf16_t* ksrc = K + rowbase * 512 + h * 128 + c * 64 + (size_t)lane * 512 + wid * 8;
        const bf16_t* vsrc = V + rowbase * 512 + h * 128 + (size_t)(16 * (wid & 3) + (lane >> 2)) * 512 + (wid >> 2) * 32 + (lane & 3) * 8;
#define ATT_DMA(t, s) do { \
        __builtin_amdgcn_global_load_lds((const unsigned*)(ksrc + (size_t)(t) * 64 * 512), (ATT_LAS unsigned*)(lds + L_K + (s) * KSLOT + ldsw), 16, 0, 0); \
        __builtin_amdgcn_global_load_lds((const unsigned*)(vsrc + (size_t)(t) * 64 * 512), (ATT_LAS unsigned*)(lds + L_V + (s) * VSLOT + vpiece), 16, 0, 0); \
        __builtin_amdgcn_global_load_lds((const unsigned*)(vsrc + (size_t)(t) * 64 * 512 + 64), (ATT_LAS unsigned*)(lds + L_V + (s) * VSLOT + vpiece + 8192), 16, 0, 0); } while (0)
        __syncthreads();
        ATT_DMA(0, 0);
        bf16x8 qr[4];
#pragma unroll
        for (int d0 = 0; d0 < 4; ++d0) qr[d0] = *(const bf16x8*)(Qw + (size_t)r32 * 512 + d0 * 16 + hi * 8);
        f32x16 o[4];
#pragma unroll
        for (int d0 = 0; d0 < 4; ++d0)
#pragma unroll
            for (int r = 0; r < 16; ++r) o[d0][r] = 0.f;
        float mhat = 0.f, l_reg = 0.f; bool init_done = false;
#pragma unroll 1
        for (int t = 0; t < NT; ++t) {
            const int s = t & 1;
            ATT_WAIT_BAR();
            if (t + 1 < NT) ATT_DMA(t + 1, s ^ 1);
            const ATT_LAS unsigned char* kp = lds + L_K + s * KSLOT + krd;
            bf16x8 kf[8];
#pragma unroll
            for (int d0 = 0; d0 < 4; ++d0) { kf[2 * d0] = *(const ATT_LAS bf16x8*)(kp + d0 * 2048); kf[2 * d0 + 1] = *(const ATT_LAS bf16x8*)(kp + d0 * 2048 + 512); }
            f32x16 p0, p1;
            const int k0 = t * 64, rlo = k0 - (q0 + 31), rhi = k0 + 63 - q0;
            for (;;) {
                if (rhi <= -91 || rlo >= 91) { const float cv = (rhi <= -91 ? bl : br) - mhat;
#pragma unroll
                    for (int r = 0; r < 16; ++r) { p0[r] = cv; p1[r] = cv; } }
                else { const int dq = k0 + 4 * hi - (q0 + r32);
#pragma unroll
                    for (int r = 0; r < 16; ++r) { int d = dq + (r & 3) + 8 * (r >> 2); int d1 = d + 32;
                        d = d < -128 ? -128 : (d > 128 ? 128 : d); d1 = d1 < -128 ? -128 : (d1 > 128 ? 128 : d1);
                        p0[r] = btab[d + 128] - mhat; p1[r] = btab[d1 + 128] - mhat; } }
#pragma unroll
                for (int d0 = 0; d0 < 4; ++d0) { p0 = ATT_MFMA(kf[2 * d0], qr[d0], p0); p1 = ATT_MFMA(kf[2 * d0 + 1], qr[d0], p1); }
                float rm;
                { float a = fmaxf(fmaxf(p0[0], p0[1]), p1[0]), bq = fmaxf(fmaxf(p0[2], p0[3]), p1[1]); a = fmaxf(fmaxf(a, p1[2]), p1[3]);
#pragma unroll
                  for (int r = 4; r < 16; r += 4) { a = fmaxf(fmaxf(a, p0[r]), p0[r + 1]); bq = fmaxf(fmaxf(bq, p0[r + 2]), p0[r + 3]); a = fmaxf(fmaxf(a, p1[r]), p1[r + 1]); bq = fmaxf(fmaxf(bq, p1[r + 2]), p1[r + 3]); }
                  rm = fmaxf(a, bq); auto rr = __builtin_amdgcn_permlane32_swap(__float_as_uint(rm), __float_as_uint(rm), false, false); rm = fmaxf(__uint_as_float(rr[0]), __uint_as_float(rr[1])); }
                if (!init_done) { mhat = rm; init_done = true; continue; }
                if (!__any(rm > (float)THRL)) break;
                const float dl = fmaxf(rm, 0.f); mhat += dl;
                const float f = __builtin_amdgcn_exp2f(-dl); l_reg *= f; if (hi == 0) wsf[r32] = f;
                asm volatile("s_waitcnt lgkmcnt(0)" ::: "memory");
                float frs[16];
#pragma unroll
                for (int r = 0; r < 16; ++r) frs[r] = wsf[crow(r, hi)];
#pragma unroll
                for (int d0 = 0; d0 < 4; ++d0)
#pragma unroll
                    for (int r = 0; r < 16; ++r) o[d0][r] *= frs[r];
                asm volatile("s_waitcnt lgkmcnt(0)" ::: "memory");
            }
            float sacc = 0.f;
#pragma unroll
            for (int r = 0; r < 16; ++r) { p0[r] = __builtin_amdgcn_exp2f(p0[r]); p1[r] = __builtin_amdgcn_exp2f(p1[r]); sacc += p0[r] + p1[r]; }
            l_reg += sacc;
            u32x4 pw[4];
#pragma unroll
            for (int j = 0; j < 4; ++j) { pw[0][j] = cvtpk(p0[2 * j], p0[2 * j + 1]); pw[1][j] = cvtpk(p0[8 + 2 * j], p0[9 + 2 * j]); pw[2][j] = cvtpk(p1[2 * j], p1[2 * j + 1]); pw[3][j] = cvtpk(p1[8 + 2 * j], p1[9 + 2 * j]); }
            __builtin_amdgcn_sched_barrier(0);
            const ATT_LAS unsigned char* vp = lds + L_V + s * VSLOT + vrd;
#pragma unroll
            for (int d0 = 0; d0 < 4; ++d0) {
                s16x4 vl[4], vh[4];
#pragma unroll
                for (int ks = 0; ks < 4; ++ks) { vl[ks] = vtr(vp + d0 * 4096 + ks * 1024); vh[ks] = vtr(vp + d0 * 4096 + ks * 1024 + 512); }
#pragma unroll
                for (int ks = 0; ks < 4; ++ks) { const bf16x8 vf = (bf16x8){vl[ks][0], vl[ks][1], vl[ks][2], vl[ks][3], vh[ks][0], vh[ks][1], vh[ks][2], vh[ks][3]};
                    o[d0] = ATT_MFMA(__builtin_bit_cast(bf16x8, pw[ks]), vf, o[d0]); }
                __builtin_amdgcn_sched_barrier(0);
            }
        }
        { auto rr = __builtin_amdgcn_permlane32_swap(__float_as_uint(l_reg), __float_as_uint(l_reg), false, false); l_reg = __uint_as_float(rr[0]) + __uint_as_float(rr[1]); }
        if (hi == 0) wsf[32 + r32] = l_reg;
        asm volatile("s_waitcnt lgkmcnt(0)" ::: "memory");
        float rli[16];
#pragma unroll
        for (int r = 0; r < 16; ++r) rli[r] = __builtin_amdgcn_rcpf(wsf[32 + crow(r, hi)]);
        asm volatile("s_waitcnt lgkmcnt(0)" ::: "memory");
        size_t sbase = (rowbase + q0 + 4 * hi) * 512 + h * 128 + r32; asm volatile("" : "+v"(sbase));
        float* st = stash + sbase;
        if (c == 0) {
#pragma unroll
            for (int r = 0; r < 16; ++r)
#pragma unroll
                for (int d0 = 0; d0 < 4; ++d0) st[(size_t)((r & 3) + 8 * (r >> 2)) * 512 + d0 * 32] = o[d0][r] * rli[r];
        } else {
#ifndef NO_EPI1
            float ss[16];
#pragma unroll
            for (int r = 0; r < 16; ++r) { float sq = 0.f;
#pragma unroll
                for (int d0 = 0; d0 < 4; ++d0) { const float dv = st[(size_t)((r & 3) + 8 * (r >> 2)) * 512 + d0 * 32] - lam * (o[d0][r] * rli[r]); o[d0][r] = dv; sq += dv * dv; }
                ss[r] = sq; if ((r & 3) == 3) asm volatile("" ::: "memory"); }
#pragma unroll
            for (int off = 1; off < 32; off <<= 1)
#pragma unroll
                for (int r = 0; r < 16; ++r) ss[r] += __shfl_xor(ss[r], off);
            float g4[4];
#pragma unroll
            for (int d0 = 0; d0 < 4; ++d0) g4[d0] = subln[d0 * 32 + r32] * 0.8f;
            ATT_LAS bf16_t* stg = (ATT_LAS bf16_t*)(lds + L_OST) + wid * 4096;
#pragma unroll
            for (int r = 0; r < 16; ++r) { const float rs = __builtin_amdgcn_rsqf(ss[r] * (1.0f / 128.0f) + 1e-6f);
#pragma unroll
                for (int d0 = 0; d0 < 4; ++d0) { const float v = o[d0][r] * rs * g4[d0]; const unsigned u = __float_as_uint(v); stg[crow(r, hi) * 128 + d0 * 32 + r32] = (bf16_t)((u + 0x7fffu + ((u >> 16) & 1u)) >> 16); } }
            asm volatile("s_waitcnt lgkmcnt(0)" ::: "memory");
            size_t obase = (rowbase + q0 + (lane >> 4)) * 1024 + h * 128 + (lane & 15) * 8; asm volatile("" : "+v"(obase));
            bf16_t* Ow = A2 + obase;
#pragma unroll
            for (int i = 0; i < 8; ++i) { const int row = i * 4 + (lane >> 4), ch = lane & 15; const u32x4 v = *(const ATT_LAS u32x4*)(stg + row * 128 + ch * 8); *(u32x4*)(Ow + (size_t)(i * 4) * 1024) = v; }
            asm volatile("s_waitcnt lgkmcnt(0)" ::: "memory");
#endif
        }
#undef ATT_DMA
    }
}
}

namespace hyc {
#define HYC_LAS __attribute__((address_space(3)))
#define HYC_GAS __attribute__((address_space(1)))
typedef short bf16x8 __attribute__((ext_vector_type(8)));
typedef bf16x8 ubf16x8 __attribute__((aligned(2)));
typedef float f32x16 __attribute__((ext_vector_type(16)));
typedef unsigned u32x4 __attribute__((ext_vector_type(4)));
typedef u32x4 u32x4a4 __attribute__((aligned(4)));
typedef unsigned short bf16_t;
constexpr int SEQ = 8192, M = 16384, GPITCH = 16384 + 64;
constexpr int UBLK = 144, UBOFF = 160 * UBLK;
constexpr int L_U = 0, L_T0 = 49152, L_T1 = 81920, L_F0 = 49152, L_F1 = L_F0 + 32768 + 68, L_END = L_F1 + 32768;
static_assert(2 * UBOFF <= L_T0 && (UBOFF % 256) == 0 && L_END <= 131072, "conv LDS map");
__device__ __forceinline__ float bf2f(bf16_t b) { return __builtin_bit_cast(float, (unsigned)b << 16); }
__device__ __forceinline__ unsigned f2bf(float f) { unsigned u = __builtin_bit_cast(unsigned, f); return (u + 0x7fffu + ((u >> 16) & 1u)) >> 16; }
__device__ __forceinline__ int crow(int r, int hi) { return (r & 3) + 8 * (r >> 2) + 4 * hi; }

__device__ __forceinline__ void sconv8(const HYC_LAS bf16_t* T, int m0, float w0, float w1, float w2, float bb, float (&u)[8]) {
    const u32x4 v = *(const HYC_LAS u32x4*)(T + m0);
    float z[10]; const int t = m0 & (SEQ - 1);
    z[0] = t > 0 ? bf2f(T[m0 - 1]) : 0.f; z[9] = t + 8 < SEQ ? bf2f(T[m0 + 8]) : 0.f;
#pragma unroll
    for (int j = 0; j < 4; ++j) { z[1 + 2 * j] = __builtin_bit_cast(float, v[j] << 16); z[2 + 2 * j] = __builtin_bit_cast(float, v[j] & 0xffff0000u); }
#pragma unroll
    for (int j = 0; j < 8; ++j) u[j] = bb + w0 * z[j] + w1 * z[j + 1] + w2 * z[j + 2];
}

__device__ __forceinline__ void conv_channel(HYC_LAS unsigned char* lds, int c, const bf16_t* ZT, const bf16_t* GR, const float* cw, const float* cb, float hb, bf16_t* YT) {
    int tid_ = threadIdx.x; asm volatile("" : "+v"(tid_));
    const int tid = tid_, lane = tid & 63, r32 = lane & 31, hi = lane >> 5; const int wid = __builtin_amdgcn_readfirstlane(tid >> 6);
    HYC_LAS bf16_t* T0 = (HYC_LAS bf16_t*)(lds + L_T0); HYC_LAS bf16_t* T1 = (HYC_LAS bf16_t*)(lds + L_T1);
    const bf16_t* z0row = ZT + (size_t)c * M;
    __syncthreads();
    for (int i = tid; i < M / 8; i += 512) ((HYC_LAS u32x4*)T0)[i] = ((const HYC_GAS u32x4*)z0row)[i];
    __syncthreads();
    { const float w0 = cw[c], w1 = cw[1536 + c], w2 = cw[3072 + c], bb = cb[c];
      for (int i = tid; i < M / 8; i += 512) { float u[8]; sconv8(T0, i * 8, w0, w1, w2, bb, u);
          u32x4 o; o.x = f2bf(u[0]) | (f2bf(u[1]) << 16); o.y = f2bf(u[2]) | (f2bf(u[3]) << 16); o.z = f2bf(u[4]) | (f2bf(u[5]) << 16); o.w = f2bf(u[6]) | (f2bf(u[7]) << 16);
          ((HYC_GAS u32x4*)(YT + (size_t)c * M))[i] = o; } }
    __syncthreads();
    for (int i = tid; i < M / 8; i += 512) { ((HYC_LAS u32x4*)T0)[i] = ((const HYC_GAS u32x4*)(ZT + (size_t)(512 + c) * M))[i]; ((HYC_LAS u32x4*)T1)[i] = ((const HYC_GAS u32x4*)(ZT + (size_t)(1024 + c) * M))[i]; }
    for (int i = tid; i < 2 * 2 * 16 * (UBLK / 16); i += 512) { const int b = i / (2 * 16 * 9), rem = i % (2 * 16 * 9), side = rem / (16 * 9), q = rem % (16 * 9);
        *(HYC_LAS u32x4*)(lds + L_U + b * UBOFF + side * (144 * UBLK) + q * 16) = (u32x4){0u, 0u, 0u, 0u}; }
    __syncthreads();
    { const float a0 = cw[512 + c], a1 = cw[1536 + 512 + c], a2 = cw[3072 + 512 + c], ab = cb[512 + c];
      const float v0 = cw[1024 + c], v1 = cw[1536 + 1024 + c], v2 = cw[3072 + 1024 + c], vb = cb[1024 + c];
      for (int i = tid; i < M / 8; i += 512) { float ux[8], uv[8]; sconv8(T0, i * 8, a0, a1, a2, ab, ux); sconv8(T1, i * 8, v0, v1, v2, vb, uv);
          u32x4 o; o.x = f2bf(ux[0] * uv[0]) | (f2bf(ux[1] * uv[1]) << 16); o.y = f2bf(ux[2] * uv[2]) | (f2bf(ux[3] * uv[3]) << 16);
          o.z = f2bf(ux[4] * uv[4]) | (f2bf(ux[5] * uv[5]) << 16); o.w = f2bf(ux[6] * uv[6]) | (f2bf(ux[7] * uv[7]) << 16);
          const int m0 = i * 8, b = m0 >> 13, t = m0 & (SEQ - 1);
          *(HYC_LAS u32x4*)(lds + L_U + b * UBOFF + ((t >> 6) + 16) * UBLK + (t & 63) * 2) = o; } }
    __syncthreads();
    { const bf16_t* gb = GR + (size_t)c * GPITCH; const bf16_t* gf = gb + 8192;
      HYC_LAS bf16_t* F0 = (HYC_LAS bf16_t*)(lds + L_F0);
      for (int i = tid; i < 8192 / 8; i += 512) { const u32x4 vb = ((const HYC_GAS u32x4*)gb)[i], vf = ((const HYC_GAS u32x4*)gf)[i];
          ((HYC_LAS u32x4*)(F0 + 8192))[i] = vb;
          HYC_LAS bf16_t* d = F0 + 8192 - 8 * i;
          if (i > 0) d[0] = (bf16_t)(vf.x & 0xffffu);
          d[-1] = (bf16_t)(vf.x >> 16); d[-2] = (bf16_t)(vf.y & 0xffffu); d[-3] = (bf16_t)(vf.y >> 16); d[-4] = (bf16_t)(vf.z & 0xffffu); d[-5] = (bf16_t)(vf.z >> 16);
          d[-6] = (bf16_t)(vf.w & 0xffffu); d[-7] = (bf16_t)(vf.w >> 16); }
      if (tid == 0) F0[0] = 0; }
    __syncthreads();
    { const HYC_LAS unsigned* s0 = (const HYC_LAS unsigned*)(lds + L_F0); HYC_LAS unsigned* s1 = (HYC_LAS unsigned*)(lds + L_F1);
      for (int w = tid; w < 8192; w += 512) { const unsigned a = s0[w], b2 = s0[w + 1 < 8192 ? w + 1 : 8191]; s1[w] = (a >> 16) | (b2 << 16); } }
    __syncthreads();
    const int i0 = 16 * wid, dlo = i0 - 127;
    const int il = r32 & 15, bb_ = r32 >> 4;
    int aoff = L_U + bb_ * UBOFF + (i0 + il - dlo + 16) * UBLK + hi * 16;
    int goff = ((r32 & 1) ? (L_F1 - 2) : L_F0) + 2 * (8192 - (64 * dlo + r32 - 8 * hi));
#define HYC_LDF(off) __builtin_bit_cast(bf16x8, *(const HYC_LAS u32x4a4*)(lds + (off)))
    bf16x8 f0 = HYC_LDF(goff - 64), f1 = HYC_LDF(goff - 32), f2 = HYC_LDF(goff), f3 = HYC_LDF(goff + 32), f4 = HYC_LDF(goff + 64), f5 = HYC_LDF(goff + 96);
    f32x16 acc0, acc1;
#pragma unroll
    for (int r = 0; r < 16; ++r) { acc0[r] = 0.f; acc1[r] = 0.f; }
#pragma unroll 1
    for (int e = 0; e < 143; ++e) {
        const int gn = goff - (e < 142 ? 128 : 0);
        const bf16x8 n0 = HYC_LDF(gn - 64), n1 = HYC_LDF(gn - 32), n2 = HYC_LDF(gn), n3 = HYC_LDF(gn + 32);
        const bf16x8 a0 = *(const HYC_LAS bf16x8*)(lds + aoff), a1 = *(const HYC_LAS bf16x8*)(lds + aoff + 32), a2 = *(const HYC_LAS bf16x8*)(lds + aoff + 64), a3 = *(const HYC_LAS bf16x8*)(lds + aoff + 96);
        acc0 = __builtin_amdgcn_mfma_f32_32x32x16_bf16(a0, f2, acc0, 0, 0, 0); acc1 = __builtin_amdgcn_mfma_f32_32x32x16_bf16(a0, f0, acc1, 0, 0, 0);
        acc0 = __builtin_amdgcn_mfma_f32_32x32x16_bf16(a1, f3, acc0, 0, 0, 0); acc1 = __builtin_amdgcn_mfma_f32_32x32x16_bf16(a1, f1, acc1, 0, 0, 0);
        acc0 = __builtin_amdgcn_mfma_f32_32x32x16_bf16(a2, f4, acc0, 0, 0, 0); acc1 = __builtin_amdgcn_mfma_f32_32x32x16_bf16(a2, f2, acc1, 0, 0, 0);
        acc0 = __builtin_amdgcn_mfma_f32_32x32x16_bf16(a3, f5, acc0, 0, 0, 0); acc1 = __builtin_amdgcn_mfma_f32_32x32x16_bf16(a3, f3, acc1, 0, 0, 0);
        f4 = f0; f5 = f1; f0 = n0; f1 = n1; f2 = n2; f3 = n3; goff = gn; aoff -= UBLK;
    }
#undef HYC_LDF
    bf16_t* yrow = YT + (size_t)c * M;
#pragma unroll
    for (int nt = 0; nt < 2; ++nt)
#pragma unroll
        for (int r = 0; r < 16; ++r) { const int rho = crow(r, hi), i = i0 + (rho & 15), b = rho >> 4, t = 64 * i + 32 * nt + r32, m = b * SEQ + t;
            const float vx = bf2f(*(const HYC_LAS bf16_t*)(lds + L_U + b * UBOFF + (i + 16) * UBLK + (32 * nt + r32) * 2));
            const float x0 = bf2f(yrow[m]);
            const float a = nt == 0 ? acc0[r] : acc1[r];
            yrow[m] = (bf16_t)f2bf((a + vx * hb) * x0); }
}
}
#ifndef DUPMASK
#define DUPMASK 0
#endif

constexpr int NWAVES = 8;
constexpr int BATCH = 2, SEQ = 8192, D = 1024, M = BATCH * SEQ, FF = 2816, DIN = 3072, NH = 4;
constexpr float EPS = 1e-6f;
constexpr float LOG2E = 1.4426950408889634f;
constexpr float C2 = 0.125f * LOG2E;

constexpr size_t MiB = 1u << 20;
constexpr size_t WS_CTL = 0, CTL_ZERO_BYTES = 64 * 1024;
constexpr size_t WS_WGU1 = 1 * MiB;
constexpr size_t WS_WD1 = 12 * MiB;
constexpr size_t WS_WIN = 18 * MiB;
constexpr size_t WS_WOUT = 24 * MiB;
constexpr size_t WS_WGU2 = 26 * MiB;
constexpr size_t WS_WD2 = 37 * MiB;
constexpr size_t WS_SSQ = 43 * MiB;
constexpr size_t WS_G = 45 * MiB;
constexpr int GPITCH = 16384 + 64;
constexpr size_t WS_XB = 62 * MiB;
constexpr size_t WS_X1 = 94 * MiB;
constexpr size_t WS_H = 158 * MiB;
constexpr size_t WS_Q = WS_H, WS_K = WS_H + 16 * MiB, WS_V = WS_H + 32 * MiB;
constexpr size_t WS_A2 = WS_H + 48 * MiB;
constexpr size_t WS_END = 246 * MiB;
constexpr size_t DO_ZT = 0, DO_YT = 48 * MiB;
constexpr int CW_TMO = 0, CW_BAR = 4096;

constexpr int RING_OFF = 0, RING_BYTES = 131072;
constexpr int LDSCTL_OFF = RING_BYTES, MISC_OFF = LDSCTL_OFF + 320;
constexpr int LDS_BYTES = 147456;

struct Frame {
    LAS unsigned char* lds;
    volatile LAS unsigned* MISC;
    gu32* ctl;
    int tid, lane, wave;
    int vcu, G;
};

__device__ __forceinline__ float bf2f(bf16 b) { return __builtin_bit_cast(float, (unsigned)b << 16); }
__device__ __forceinline__ float wave_sum(float v) {
#pragma unroll
    for (int o = 1; o < 64; o <<= 1) v += __shfl_xor(v, o);
    return v;
}

__device__ __forceinline__ void p0_transpose_item(const float* W, const float* gain, int K, int N, bf16* WT, int item, int mode, int up, LAS float* scr, int lane) {
    const int nblk = N / 32, kb = item / nblk, nb = item % nblk, k0 = 64 * kb, n0 = 32 * nb;
    const int dst_row0 = mode ? (256 * (n0 / 128) + (n0 % 128) + 128 * up) : n0;
    const int q = lane >> 3, c4 = (lane & 7) * 4;
    f32x4 v[8]; float g[8];
#pragma unroll
    for (int j = 0; j < 8; ++j) { v[j] = *(const GAS f32x4*)(W + (size_t)(k0 + 8 * j + q) * N + n0 + c4); g[j] = gain ? gain[k0 + 8 * j + q] : 1.0f; }
#pragma unroll
    for (int j = 0; j < 8; ++j) { LAS float* d = scr + (8 * j + q) * 33 + c4; d[0] = v[j].x * g[j]; d[1] = v[j].y * g[j]; d[2] = v[j].z * g[j]; d[3] = v[j].w * g[j]; }
    LDS_WAIT(); asm volatile("" ::: "memory");
    const int c = lane & 7;
#pragma unroll
    for (int j = 0; j < 4; ++j) { const int n = (lane >> 3) + 8 * j; const LAS float* s = scr + (8 * c) * 33 + n;
        v4u o; o.x = pk2(s[0 * 33], s[1 * 33]); o.y = pk2(s[2 * 33], s[3 * 33]); o.z = pk2(s[4 * 33], s[5 * 33]); o.w = pk2(s[6 * 33], s[7 * 33]);
        *(GAS v4u*)(WT + (size_t)(dst_row0 + n) * K + k0 + 8 * c) = o; }
    LDS_WAIT(); asm volatile("" ::: "memory");
}
__device__ __forceinline__ void row_to_bf16_ssq2(const float* x0, const float* x1, bf16* o0, bf16* o1, float* s0, float* s1, int lane) {
    f32x4 a[4], b[4];
#pragma unroll
    for (int p = 0; p < 4; ++p) { a[p] = *(const GAS f32x4*)(x0 + p * 256 + lane * 4); b[p] = *(const GAS f32x4*)(x1 + p * 256 + lane * 4); }
#pragma unroll
    for (int p = 0; p < 4; ++p) { const float sa = wave_sum((a[p].x * a[p].x + a[p].y * a[p].y) + (a[p].z * a[p].z + a[p].w * a[p].w)), sb = wave_sum((b[p].x * b[p].x + b[p].y * b[p].y) + (b[p].z * b[p].z + b[p].w * b[p].w));
        if (lane == 0) { s0[p] = sa; s1[p] = sb; }
        *(GAS unsigned long long*)(o0 + p * 256 + lane * 4) = (unsigned long long)pk2(a[p].x, a[p].y) | ((unsigned long long)pk2(a[p].z, a[p].w) << 32);
        *(GAS unsigned long long*)(o1 + p * 256 + lane * 4) = (unsigned long long)pk2(b[p].x, b[p].y) | ((unsigned long long)pk2(b[p].z, b[p].w) << 32); }
}
__device__ __forceinline__ void p0_filters_unit(Frame& F, const float* const* in, bf16* G, int u) {
    LAS float* a3s = (LAS float*)(F.lds + RING_OFF);
    const float *w1 = in[15], *b1 = in[16], *w2 = in[17], *b2 = in[18], *w3 = in[19], *b3 = in[20], *w4 = in[21], *freq = in[22];
    const int lane = F.lane; const float fr = freq[lane];
    for (int repm_ = 0; repm_ < (((DUPMASK >> 11) & 1) ? 2 : 1); ++repm_)
    { float aq[4];
#pragma unroll
      for (int q = 0; q < 4; ++q) { const int i = 32 * u + F.wave * 4 + q; float z = 0.f;
          const float w = (6.283185307179586f * (float)i) / (float)SEQ; const int j = (lane - 1) & 15; const float f = 1e-4f + (float)j * ((15.0f - 1e-4f) / 15.0f); const float fw = f * w;
          if (lane == 0) z = (float)i / (float)(SEQ - 1); else if (lane <= 16) z = cosf(fw); else if (lane <= 32) z = -sinf(fw);
          aq[q] = z; }
      { float r[33]; const float c1 = b1[lane];
#pragma unroll
        for (int ch = 0; ch < 3; ++ch) { const float* wc = w1 + ch * 1024 + lane; asm volatile("" : "+v"(wc));
#pragma unroll
            for (int e = 0; e < 16; ++e) if (ch * 16 + e < 33) r[ch * 16 + e] = wc[e * 64]; }
#pragma unroll
        for (int q = 0; q < 4; ++q) { float s = c1;
#pragma unroll
            for (int e = 0; e < 33; ++e) s += __shfl(aq[q], e) * r[e];
            aq[q] = sinf(fr * s); } }
      asm volatile("" ::: "memory");
#pragma unroll 1
      for (int layer = 0; layer < 2; ++layer) { const float* wl = layer ? w3 : w2; const float cb_ = (layer ? b3 : b2)[lane]; float r[64];
#pragma unroll
        for (int ch = 0; ch < 4; ++ch) { const float* wc = wl + ch * 1024 + lane; asm volatile("" : "+v"(wc));
#pragma unroll
            for (int e = 0; e < 16; ++e) r[ch * 16 + e] = wc[e * 64]; }
#pragma unroll
        for (int q = 0; q < 4; ++q) { float s = cb_;
#pragma unroll
            for (int e = 0; e < 64; ++e) s += __shfl(aq[q], e) * r[e];
            aq[q] = sinf(fr * s); }
        asm volatile("" ::: "memory"); }
#pragma unroll
      for (int q = 0; q < 4; ++q) a3s[(F.wave * 4 + q) * 64 + lane] = aq[q]; }
    __syncthreads();
    for (int repo_ = 0; repo_ < (((DUPMASK >> 12) & 1) ? 2 : 1); ++repo_)
    { const int c = F.tid;
      const float mind = logf(1e-2f) / 1.5f, maxd = logf(1e-2f) / 0.3f; const float ad = fabsf(mind + (float)c * ((maxd - mind) / 511.0f));
      float acc0[32], acc1[32];
#pragma unroll
      for (int p = 0; p < 32; ++p) { acc0[p] = 0.f; acc1[p] = 0.f; }
      { float wa[4], wb[4], na[4], nb[4]; const float* wp = w4 + c;
#pragma unroll
        for (int kk = 0; kk < 4; ++kk) { wa[kk] = wp[kk * 1024]; wb[kk] = wp[kk * 1024 + 512]; }
#pragma unroll 1
        for (int k = 0; k < 64; k += 4) {
            const float* wn = wp + (k + 4 < 64 ? (k + 4) * 1024 : 0);
#pragma unroll
            for (int kk = 0; kk < 4; ++kk) { na[kk] = wn[kk * 1024]; nb[kk] = wn[kk * 1024 + 512]; }
#pragma unroll
            for (int p = 0; p < 32; ++p) { const f32x4 a = *(const LAS f32x4*)(a3s + p * 64 + k);
                acc0[p] += a.x * wa[0]; acc1[p] += a.x * wb[0]; acc0[p] += a.y * wa[1]; acc1[p] += a.y * wb[1]; acc0[p] += a.z * wa[2]; acc1[p] += a.z * wb[2]; acc0[p] += a.w * wa[3]; acc1[p] += a.w * wb[3]; }
#pragma unroll
            for (int kk = 0; kk < 4; ++kk) { wa[kk] = na[kk]; wb[kk] = nb[kk]; } } }
      const int i0 = 32 * u; bf16* gb = G + (size_t)c * GPITCH; bf16* gf = gb + 8192;
#pragma unroll
      for (int p8 = 0; p8 < 4; ++p8) { unsigned wb_[4], wf_[4];
#pragma unroll
          for (int h = 0; h < 4; ++h) { const int p = p8 * 8 + 2 * h; const float d0 = expf(-((float)(i0 + p) / (float)(SEQ - 1)) * ad), d1 = expf(-((float)(i0 + p + 1) / (float)(SEQ - 1)) * ad);
              const float e0 = (i0 + p == 0) ? acc0[p] : acc1[p];
              wb_[h] = pk2(e0 * d0, acc1[p + 1] * d1); wf_[h] = pk2(acc0[p] * d0, acc0[p + 1] * d1); }
          *(GAS v4u*)(gb + i0 + p8 * 8) = (v4u){wb_[0], wb_[1], wb_[2], wb_[3]}; *(GAS v4u*)(gf + i0 + p8 * 8) = (v4u){wf_[0], wf_[1], wf_[2], wf_[3]}; }
    }
    __syncthreads();
}

constexpr int I_GU = (D / 64) * (FF / 32), I_DN = (FF / 64) * (D / 32), I_IN = (D / 64) * (DIN / 32), I_OUT = (D / 64) * (D / 32);
constexpr int NITEMS = 4 * I_GU + 2 * I_DN + I_IN + I_OUT;
__device__ __forceinline__ void p0_transpose_range(Frame& F, const float* const* in, unsigned char* ws, int first, int last, int gw, int NGW) {
    LAS float* scr = (LAS float*)(F.lds + RING_OFF + F.wave * 16384);
    bf16 *Wgu1 = (bf16*)(ws + WS_WGU1), *Wd1 = (bf16*)(ws + WS_WD1), *Win = (bf16*)(ws + WS_WIN), *Wout = (bf16*)(ws + WS_WOUT), *Wgu2 = (bf16*)(ws + WS_WGU2), *Wd2 = (bf16*)(ws + WS_WD2);
    for (int it = first + gw; it < last; it += NGW) {
        int r = it;
        if (r < I_GU) { p0_transpose_item(in[3], in[2], D, FF, Wgu1, r, 1, 0, scr, F.lane); continue; } r -= I_GU;
        if (r < I_GU) { p0_transpose_item(in[4], in[2], D, FF, Wgu1, r, 1, 1, scr, F.lane); continue; } r -= I_GU;
        if (r < I_DN) { p0_transpose_item(in[5], nullptr, FF, D, Wd1, r, 0, 0, scr, F.lane); continue; } r -= I_DN;
        if (r < I_IN) { p0_transpose_item(in[7], in[6], D, DIN, Win, r, 0, 0, scr, F.lane); continue; } r -= I_IN;
        if (r < I_OUT) { p0_transpose_item(in[25], nullptr, D, D, Wout, r, 0, 0, scr, F.lane); continue; } r -= I_OUT;
        if (r < I_GU) { p0_transpose_item(in[27], in[26], D, FF, Wgu2, r, 1, 0, scr, F.lane); continue; } r -= I_GU;
        if (r < I_GU) { p0_transpose_item(in[28], in[26], D, FF, Wgu2, r, 1, 1, scr, F.lane); continue; } r -= I_GU;
        p0_transpose_item(in[29], nullptr, FF, D, Wd2, r, 0, 0, scr, F.lane);
    }
}
__device__ __forceinline__ void p0_early(Frame& F, const float* const* in, unsigned char* ws) {
    const int gw = F.vcu * NWAVES + F.wave, NGW = F.G * NWAVES;
    p0_transpose_range(F, in, ws, 0, 2 * I_GU, gw, NGW);
    bf16* XB = (bf16*)(ws + WS_XB); float* ssq = (float*)(ws + WS_SSQ);
    for (int m = 2 * gw; m < M; m += 2 * NGW) row_to_bf16_ssq2(in[0] + (size_t)m * D, in[0] + (size_t)(m + 1) * D, XB + (size_t)m * D, XB + (size_t)(m + 1) * D, ssq + (size_t)m * 4, ssq + (size_t)(m + 1) * 4, F.lane);
}
__device__ __forceinline__ void p0_late(Frame& F, const float* const* in, unsigned char* ws, int rank, int nranks) {
    __syncthreads();
    p0_transpose_range(F, in, ws, 2 * I_GU, NITEMS, rank * NWAVES + F.wave, nranks * NWAVES);
    __syncthreads();
}

__device__ __forceinline__ int t5_bucket(int rel) {
    const int n = rel < 0 ? -rel : rel; int b;
    if (n < 8) b = n; else if (n < 12) b = 8; else if (n < 16) b = 9; else if (n < 23) b = 10; else if (n < 32) b = 11;
    else if (n < 46) b = 12; else if (n < 64) b = 13; else if (n < 91) b = 14; else b = 15;
    return b + (rel > 0 ? 16 : 0);
}

__device__ __forceinline__ void hy_norm_item(int m, int g, const bf16* YT, const float* og, bf16* A2) {
    float y[64]; float ss = 0.f;
#pragma unroll
    for (int ch = 0; ch < 64; ++ch) { y[ch] = bf2f(YT[(size_t)(g * 64 + ch) * M + m]); ss += y[ch] * y[ch]; }
    const float rs = rsqrtf(ss * (1.f / 64.f) + EPS);
#pragma unroll
    for (int ch = 0; ch < 64; ch += 8) { v4u w;
        w.x = pk2(y[ch] * rs * og[g * 64 + ch], y[ch + 1] * rs * og[g * 64 + ch + 1]); w.y = pk2(y[ch + 2] * rs * og[g * 64 + ch + 2], y[ch + 3] * rs * og[g * 64 + ch + 3]);
        w.z = pk2(y[ch + 4] * rs * og[g * 64 + ch + 4], y[ch + 5] * rs * og[g * 64 + ch + 5]); w.w = pk2(y[ch + 6] * rs * og[g * 64 + ch + 6], y[ch + 7] * rs * og[g * 64 + ch + 7]);
        *(GAS v4u*)(A2 + (size_t)m * D + 512 + g * 64 + ch) = w; }
}
__device__ __forceinline__ void final_norm_row(float* xrow, const float* gain, int lane) {
    f32x4 v[4]; float s = 0.f;
#pragma unroll
    for (int p = 0; p < 4; ++p) { v[p] = *(const GAS f32x4*)(xrow + p * 256 + lane * 4); s += (v[p].x * v[p].x + v[p].y * v[p].y) + (v[p].z * v[p].z + v[p].w * v[p].w); }
    const float rs = rsqrtf(wave_sum(s) * (1.f / D) + EPS);
#pragma unroll
    for (int p = 0; p < 4; ++p) { const f32x4 g = *(const GAS f32x4*)(gain + p * 256 + lane * 4);
        *(GAS f32x4*)(xrow + p * 256 + lane * 4) = (f32x4){v[p].x * rs * g.x, v[p].y * rs * g.y, v[p].z * rs * g.z, v[p].w * rs * g.w}; }
}

#define REP(k) for (int rep_ = 0; rep_ < (((DUPMASK >> (k)) & 1) ? 2 : 1); ++rep_)
struct Args { const float* in[31]; float* out; unsigned char* ws; };
__global__ void __launch_bounds__(NWAVES * 64, 2) mega_fwd(Args args) {
    extern __shared__ __attribute__((aligned(16))) unsigned char lds[];
    Frame F;
    F.lds = (LAS unsigned char*)lds;
    F.MISC = (volatile LAS unsigned*)(F.lds + MISC_OFF);
    F.tid = threadIdx.x; F.lane = F.tid & 63; F.wave = __builtin_amdgcn_readfirstlane(F.tid >> 6);
    F.G = gridDim.x; { const int bx = blockIdx.x; F.vcu = (F.G % 8 == 0) ? (bx % 8) * (F.G / 8) + bx / 8 : bx; }
    unsigned char* ws = args.ws; unsigned char* dob = (unsigned char*)args.out;
    F.ctl = (gu32*)(ws + WS_CTL);
    const float* const* in = args.in;
    for (int u = F.tid; u < (LDS_BYTES - LDSCTL_OFF) / 4; u += NWAVES * 64) ((LAS unsigned*)(F.lds + LDSCTL_OFF))[u] = 0u;
    __syncthreads();
    XcdBarrier bar = xcd_barrier_post((unsigned*)(F.ctl + CW_BAR), F.MISC + 8);
#define GRID_BAR() xcd_barrier(bar)
#define RELAUNDER() do { int t_ = threadIdx.x; asm volatile("" : "+v"(t_)); F.tid = t_; F.lane = t_ & 63; } while (0)
    bf16 *Wgu1 = (bf16*)(ws + WS_WGU1), *Wd1 = (bf16*)(ws + WS_WD1), *Win = (bf16*)(ws + WS_WIN), *Wout = (bf16*)(ws + WS_WOUT), *Wgu2 = (bf16*)(ws + WS_WGU2), *Wd2 = (bf16*)(ws + WS_WD2);
    float* ssq = (float*)(ws + WS_SSQ); bf16* G = (bf16*)(ws + WS_G);
    bf16* XB = (bf16*)(ws + WS_XB); float* X1 = (float*)(ws + WS_X1); bf16* H = (bf16*)(ws + WS_H);
    bf16 *Qb = (bf16*)(ws + WS_Q), *Kb = (bf16*)(ws + WS_K), *Vb = (bf16*)(ws + WS_V), *A2 = (bf16*)(ws + WS_A2);
    bf16* ZT = (bf16*)(dob + DO_ZT); bf16* YT = (bf16*)(dob + DO_YT);

    RELAUNDER();
    REP(0) p0_early(F, in, ws);
    GRID_BAR();
    REP(1) { pg8::Gemm g{XB, Wgu1, M, 2 * FF, D}; pg8::StaticOrder S; S.init(M, 2 * FF, F.G, (int)blockIdx.x);
      pg8::EpiSwiglu E{H, FF, ssq};
      pg8::gemm_phase<pg8::EpiSwiglu, pg8::StaticOrder, true, true>(F.lds + RING_OFF, g, S, E); }
    RELAUNDER();
    REP(8) { __syncthreads(); for (int u = F.vcu; u < SEQ / 32; u += F.G) p0_filters_unit(F, in, G, u); }
    REP(7) { const int nwg = (M / 256) * (2 * FF / 256), nfull = nwg % F.G;
      if (nfull == 0) p0_late(F, in, ws, (int)blockIdx.x, F.G); else if ((int)blockIdx.x >= nfull) p0_late(F, in, ws, (int)blockIdx.x - nfull, F.G - nfull); }
    GRID_BAR();
    REP(2) { pg8::Gemm g{H, Wd1, M, D, FF}; pg8::StaticOrder S; S.init(M, D, F.G, (int)blockIdx.x);
      pg8::EpiResid E{in[0], X1, XB, ssq, 0.5f};
      pg8::gemm_phase<pg8::EpiResid, pg8::StaticOrder, false, true>(F.lds + RING_OFF, g, S, E); }
    GRID_BAR();
    REP(3) { pg8::Gemm g{XB, Win, M, 1536, D}; pg8::StaticOrder S; S.init(M, 1536, F.G, (int)blockIdx.x);
      pg8::EpiQKV E{Qb, (size_t)(WS_K - WS_Q) / 2, ssq, C2};
      pg8::gemm_phase<pg8::EpiQKV, pg8::StaticOrder, true, true>(F.lds + RING_OFF, g, S, E); }
    __syncthreads();
    { pg8::Gemm g{Win + (size_t)1536 * D, XB, 1536, M, D}; pg8::StaticOrder S; S.init(1536, M, F.G, (int)blockIdx.x);
      pg8::EpiZT E{ZT, M, ssq};
      pg8::gemm_phase<pg8::EpiZT, pg8::StaticOrder, true, true>(F.lds + RING_OFF, g, S, E); }
    GRID_BAR();
    REP(4) { float s1 = 0.f, s2 = 0.f;
      for (int i = 0; i < 64; ++i) { s1 += in[8][i] * in[9][i]; s2 += in[10][i] * in[11][i]; }
      const float lam = expf(s1) - expf(s2) + 0.2f;
      for (int u = F.vcu; u < 256; u += F.G) att::attn_unit<8>(F.lds + RING_OFF, u >> 7, (u >> 5) & 3, u & 31, Qb, Kb, Vb, in[1], lam, in[12], (float*)(ws + WS_XB), A2); }
    RELAUNDER();
    REP(6) for (int c = F.vcu; c < 512; c += F.G) hyc::conv_channel(F.lds + RING_OFF, c, ZT, G, in[13], in[14], in[23][c], YT);
    GRID_BAR();
    RELAUNDER();
    REP(5) for (int it = F.vcu * 512 + F.tid; it < M * 8; it += F.G * 512) hy_norm_item(it % M, it / M, YT, in[24], A2);
    GRID_BAR();
    { pg8::Gemm g{A2, Wout, M, D, D}; pg8::StaticOrder S; S.init(M, D, F.G, (int)blockIdx.x);
      pg8::EpiResid E{X1, X1, XB, ssq, 1.0f};
      pg8::gemm_phase<pg8::EpiResid, pg8::StaticOrder, false, true>(F.lds + RING_OFF, g, S, E); }
    GRID_BAR();
    { pg8::Gemm g{XB, Wgu2, M, 2 * FF, D}; pg8::StaticOrder S; S.init(M, 2 * FF, F.G, (int)blockIdx.x);
      pg8::EpiSwiglu E{H, FF, ssq};
      pg8::gemm_phase<pg8::EpiSwiglu, pg8::StaticOrder, true, true>(F.lds + RING_OFF, g, S, E); }
    GRID_BAR();
    { pg8::Gemm g{H, Wd2, M, D, FF}; pg8::StaticOrder S; S.init(M, D, F.G, (int)blockIdx.x);
      pg8::EpiResid E{X1, args.out, nullptr, nullptr, 0.5f};
      pg8::gemm_phase<pg8::EpiResid, pg8::StaticOrder, false, true>(F.lds + RING_OFF, g, S, E); }
    GRID_BAR();
    RELAUNDER();
    { const int gw = F.vcu * NWAVES + F.wave, NGW = F.G * NWAVES;
      for (int m = gw; m < M; m += NGW) final_norm_row(args.out + (size_t)m * D, in[30], F.lane); }
}

extern "C" void kernel_launch(void* const* d_in, const int* in_sizes, int n_in, void* d_out, int out_size, void* d_ws, size_t ws_size, hipStream_t stream) {
    static int grid = 0;
    if (grid == 0) {
        if (n_in != 31 || in_sizes[0] != M * D || out_size != M * D || ws_size < WS_END) { fprintf(stderr, "kernel_launch: unexpected shapes (n_in %d, ws %zu); nothing launched\n", n_in, ws_size); grid = -1; return; }
        int dev = 0, cus = 0, per_cu = 0;
        if (hipGetDevice(&dev) != hipSuccess || hipDeviceGetAttribute(&cus, hipDeviceAttributeMultiprocessorCount, dev) != hipSuccess) { grid = -1; return; }
        if (hipFuncSetAttribute((const void*)mega_fwd, hipFuncAttributeMaxDynamicSharedMemorySize, LDS_BYTES) != hipSuccess) { fprintf(stderr, "kernel_launch: hipFuncSetAttribute failed\n"); grid = -1; return; }
        if (hipOccupancyMaxActiveBlocksPerMultiprocessor(&per_cu, (const void*)mega_fwd, NWAVES * 64, LDS_BYTES) != hipSuccess || per_cu < 1)
            fprintf(stderr, "kernel_launch: note: occupancy query reports %d workgroups per CU\n", per_cu);
        (void)hipGetLastError();
        grid = cus;
        if (grid != 256) fprintf(stderr, "kernel_launch: %d CUs; the residual GEMM phases need exactly 256 workgroups\n", grid);
    }
    if (grid < 0) return;
    (void)hipMemsetAsync((char*)d_ws + WS_CTL, 0, CTL_ZERO_BYTES, stream);
    Args a{};
    for (int i = 0; i < 31; ++i) a.in[i] = (const float*)d_in[i];
    a.out = (float*)d_out; a.ws = (unsigned char*)d_ws;
    hipLaunchKernelGGL(mega_fwd, dim3(grid), dim3(NWAVES * 64), LDS_BYTES, stream, a);
}
```
